# Optimizing an MI355X kernel written in HIP

```python
import math
import jax, jax.numpy as jnp
from jax import lax
import numpy as np

D_MODEL = 1024
BATCH = 8
SEQ = 2048
DEPTH = 2
DEC_BATCH = 32
DEC_SEQ = 64
PAST_LEN = 4096

CHUNK = 64
Q_BLOCK = 128
RET_HEADS = 4
RET_DK = D_MODEL // 16
RET_DV = 2 * RET_DK
DIFF_HEADS = 4
DIFF_DH = D_MODEL // 16
DIFF_DV = 2 * DIFF_DH
D_FF = ((8 * D_MODEL // 3 + 255) // 256) * 256
ROPE_THETA = 10000.0
EPS = 1e-6
N_SUB = 3
RET_QK_W = RET_HEADS * RET_DK
RET_V_W = RET_HEADS * RET_DV
DIFF_QK_W = DIFF_HEADS * 2 * DIFF_DH
DIFF_V_W = DIFF_HEADS * DIFF_DV
IN_SIZES = (RET_QK_W, RET_QK_W, RET_V_W, RET_V_W, DIFF_QK_W, DIFF_QK_W, DIFF_V_W)
D_IN = sum(IN_SIZES)
MIX_W = RET_V_W + DIFF_V_W

kernel_name = "hybrid_retention_diffattn_streaming_step"


def _rms_norm(x, g=None):
    xf = x.astype(jnp.float32)
    y = xf * lax.rsqrt(jnp.mean(xf * xf, axis=-1, keepdims=True) + EPS)
    if g is not None:
        y = y * g.astype(jnp.float32)
    return y.astype(x.dtype)


def _swiglu(h, w_up, w_down):
    a, b = jnp.split(h @ w_up, 2, axis=-1)
    return (jax.nn.silu(a) * b) @ w_down


def _rotary(x, pos, inv_freq, interleaved):
    ang = pos.astype(jnp.float32)[:, None] * inv_freq[None, :]
    shp = (pos.shape[0],) + (1,) * (x.ndim - 3) + (inv_freq.shape[0],)
    cos = jnp.cos(ang).reshape(shp).astype(x.dtype)
    sin = jnp.sin(ang).reshape(shp).astype(x.dtype)
    if interleaved:
        x1, x2 = x[..., 0::2], x[..., 1::2]
        return jnp.stack([x1 * cos - x2 * sin, x1 * sin + x2 * cos], axis=-1).reshape(x.shape)
    x1, x2 = jnp.split(x, 2, axis=-1)
    return jnp.concatenate([x1 * cos - x2 * sin, x2 * cos + x1 * sin], axis=-1)


def _retention(q, k, v, s0):
    B, L, H, Dk = q.shape
    Dv = v.shape[-1]
    C = min(CHUNK, L)
    N = L // C
    log_g = jnp.log1p(-jnp.exp2(-5.0 - jnp.arange(H, dtype=jnp.float32)))
    idx = jnp.arange(C, dtype=jnp.float32)
    rel = idx[:, None] - idx[None, :]
    dmask = jnp.where(rel >= 0, jnp.exp(log_g[:, None, None] * jnp.maximum(rel, 0.0)), 0.0)
    q_dec = jnp.exp(log_g[None, :] * (idx[:, None] + 1.0))
    k_dec = jnp.exp(log_g[None, :] * (C - 1.0 - idx[:, None]))
    c_dec = jnp.exp(log_g * C)

    def chunks(t):
        return t.astype(jnp.float32).reshape(B, N, C, H, t.shape[-1]).swapaxes(0, 1)

    def step(S, inp):
        qi, ki, vi = inp
        att = jnp.einsum('bihd,bjhd->bhij', qi, ki) * dmask
        o = (jnp.einsum('bhij,bjhe->bihe', att, vi)
             + jnp.einsum('bihd,bhde->bihe', qi * q_dec[:, :, None], S))
        S = c_dec[:, None, None] * S + jnp.einsum('bjhd,bjhe->bhde', ki * k_dec[:, :, None], vi)
        return S, o

    S, o = lax.scan(step, s0.astype(jnp.float32), (chunks(q), chunks(k), chunks(v)))
    o = o.swapaxes(0, 1).reshape(B, L, H, Dv)
    return o.astype(v.dtype), S.astype(s0.dtype)


def _diff_attention(q, k, v, lam, q_pos, k_pos):
    B, Lq, H, _, Dh = q.shape
    Dv = v.shape[-1]
    blk = min(Q_BLOCK, Lq)
    nb = Lq // blk
    scale = Dh ** -0.5
    qb = q.reshape(B, nb, blk, H, 2, Dh).swapaxes(0, 1)
    qcb = (q_pos // CHUNK).reshape(nb, blk)
    kc = k_pos // CHUNK

    def one_block(args):
        qi, qc = args
        s = jnp.einsum('bqhcd,bkhcd->bhcqk', qi, k, preferred_element_type=jnp.float32) * scale
        s = jnp.where(qc[:, None] >= kc[None, :], s, -jnp.inf)
        p = jax.nn.softmax(s, axis=-1)
        p = p[:, :, 0] - lam * p[:, :, 1]
        return jnp.einsum('bhqk,bkhd->bqhd', p.astype(v.dtype), v)

    o = lax.map(one_block, (qb, qcb))
    return o.swapaxes(0, 1).reshape(B, Lq, H, Dv)


def _token_mix(h, pos, lambda_init, w_in, w_out, g_qk, w_lambda, g_sub, kv_past, s0):
    B, L, _ = h.shape
    split_points = np.cumsum(IN_SIZES)[:-1].tolist()
    rq, rk, rv, rg, dq, dk, dv = jnp.split(h @ w_in, split_points, axis=-1)
    ret_freq = 1.0 / (ROPE_THETA ** jnp.linspace(0.0, 1.0, RET_DK // 2, dtype=jnp.float32))
    rq = _rotary(rq.reshape(B, L, RET_HEADS, RET_DK), pos, ret_freq, True)
    rk = _rotary(rk.reshape(B, L, RET_HEADS, RET_DK), pos, ret_freq, True) * (RET_DK ** -0.5)
    rv = rv.reshape(B, L, RET_HEADS, RET_DV)
    o_r, s_new = _retention(rq, rk, rv, s0)
    o_r = _rms_norm(o_r).reshape(B, L, RET_V_W) * jax.nn.silu(rg)
    rope_freq = 1.0 / (ROPE_THETA ** (jnp.arange(0, DIFF_DH, 2, dtype=jnp.float32) / DIFF_DH))
    dq = _rotary(_rms_norm(dq.reshape(B, L, DIFF_HEADS, 2, DIFF_DH), g_qk[0]), pos, rope_freq, False)
    dk = _rotary(_rms_norm(dk.reshape(B, L, DIFF_HEADS, 2, DIFF_DH), g_qk[1]), pos, rope_freq, False)
    dv = dv.reshape(B, L, DIFF_HEADS, DIFF_DV)
    wl = w_lambda.astype(jnp.float32)
    lam = jnp.exp(jnp.sum(wl[0] * wl[1])) - jnp.exp(jnp.sum(wl[2] * wl[3])) + lambda_init
    if kv_past is None:
        k_all, v_all, k_pos = dk, dv, pos
    else:
        k_all = jnp.concatenate([kv_past[0].astype(dk.dtype), dk], axis=1)
        v_all = jnp.concatenate([kv_past[1].astype(dv.dtype), dv], axis=1)
        k_pos = jnp.arange(k_all.shape[1])
    o_d = _diff_attention(dq, k_all, v_all, lam, pos, k_pos)
    o_d = _rms_norm(o_d, g_sub) * (1.0 - lambda_init)
    mix = jnp.concatenate([o_r, o_d.reshape(B, L, DIFF_V_W)], axis=-1) @ w_out
    return mix, dk, dv, s_new


def _layer(x, c, pos, l, w_ada, b_ada, g_norm, w_ff_up, w_ff_down, w_in, w_out, g_qk, w_lambda, g_sub,
           kv_past, s0):
    B = x.shape[0]
    mod = (jax.nn.silu(c) @ w_ada[l] + b_ada[l]).reshape(B, N_SUB, 3, D_MODEL)[:, :, :, None, :]

    def pre(t, i):
        return _rms_norm(t, g_norm[l, i]) * (1.0 + mod[:, i, 1]) + mod[:, i, 0]

    lambda_init = 0.8 - 0.6 * math.exp(-0.3 * l)
    x = x + 0.5 * mod[:, 0, 2] * _swiglu(pre(x, 0), w_ff_up[l, 0], w_ff_down[l, 0])
    mix, k_new, v_new, s_new = _token_mix(pre(x, 1), pos, lambda_init, w_in[l], w_out[l], g_qk[l],
                                          w_lambda[l], g_sub[l], kv_past, s0)
    x = x + mod[:, 1, 2] * mix
    x = x + 0.5 * mod[:, 2, 2] * _swiglu(pre(x, 2), w_ff_up[l, 1], w_ff_down[l, 1])
    return x, k_new, v_new, s_new


def setup_inputs(seed: int = 0) -> dict:
    key = jax.random.key(seed)
    ks = jax.random.split(key, 20)
    f32 = jnp.float32
    nrm = lambda k, shp, s: jax.random.normal(k, shp, f32) * s
    return {
        "x_prompt": nrm(ks[0], (BATCH, SEQ, D_MODEL), 1.0),
        "x_sample": nrm(ks[1], (DEC_BATCH, DEC_SEQ, D_MODEL), 1.0),
        "cache_k": nrm(ks[2], (DEPTH, DEC_BATCH, PAST_LEN, DIFF_HEADS, 2, DIFF_DH), 1.0),
        "cache_v": nrm(ks[3], (DEPTH, DEC_BATCH, PAST_LEN, DIFF_HEADS, DIFF_DV), 1.0),
        "state_ret": nrm(ks[4], (DEPTH, DEC_BATCH, RET_HEADS, RET_DK, RET_DV), 0.5),
        "c_prompt": nrm(ks[5], (BATCH, D_MODEL), 1.0),
        "c_sample": nrm(ks[6], (DEC_BATCH, D_MODEL), 1.0),
        "w_ada": nrm(ks[7], (DEPTH, D_MODEL, N_SUB * 3 * D_MODEL), 0.5 * D_MODEL ** -0.5),
        "b_ada": nrm(ks[8], (DEPTH, N_SUB * 3 * D_MODEL), 0.01),
        "g_norm": 1.0 + nrm(ks[9], (DEPTH, N_SUB, D_MODEL), 0.01),
        "w_ff_up": nrm(ks[10], (DEPTH, 2, D_MODEL, 2 * D_FF), D_MODEL ** -0.5),
        "w_ff_down": nrm(ks[11], (DEPTH, 2, D_FF, D_MODEL), D_FF ** -0.5),
        "w_in": nrm(ks[12], (DEPTH, D_MODEL, D_IN), D_MODEL ** -0.5),
        "w_out": nrm(ks[13], (DEPTH, MIX_W, D_MODEL), MIX_W ** -0.5),
        "g_qk": 1.0 + nrm(ks[14], (DEPTH, 2, DIFF_DH), 0.01),
        "w_lambda": nrm(ks[15], (DEPTH, 4, DIFF_DH), 0.1),
        "g_sub": 1.0 + nrm(ks[16], (DEPTH, DIFF_DV), 0.01),
    }


def reference(x_prompt, x_sample, cache_k, cache_v, state_ret, c_prompt, c_sample, w_ada, b_ada, g_norm,
              w_ff_up, w_ff_down, w_in, w_out, g_qk, w_lambda, g_sub):
    past = cache_k.shape[2]
    pos_p = jnp.arange(x_prompt.shape[1])
    pos_s = past + jnp.arange(x_sample.shape[1])
    yp, ys = x_prompt, x_sample
    kp, vp, sp, ksl, vsl, ssl = [], [], [], [], [], []
    for l in range(DEPTH):
        s0 = jnp.zeros((x_prompt.shape[0], RET_HEADS, RET_DK, RET_DV), jnp.float32)
        yp, k_new, v_new, s_new = _layer(yp, c_prompt, pos_p, l, w_ada, b_ada, g_norm, w_ff_up, w_ff_down,
                                         w_in, w_out, g_qk, w_lambda, g_sub, None, s0)
        kp.append(k_new); vp.append(v_new); sp.append(s_new)
        ys, k_new, v_new, s_new = _layer(ys, c_sample, pos_s, l, w_ada, b_ada, g_norm, w_ff_up, w_ff_down,
                                         w_in, w_out, g_qk, w_lambda, g_sub, (cache_k[l], cache_v[l]),
                                         state_ret[l])
        ksl.append(k_new); vsl.append(v_new); ssl.append(s_new)
    return (yp, ys, jnp.stack(kp), jnp.stack(vp), jnp.stack(sp), jnp.stack(ksl), jnp.stack(vsl), jnp.stack(ssl))
```

```cpp
#include <hip/hip_runtime.h>
#include <cstdio>
#include <cstdint>
namespace pg8 {
#define PG8_LAS __attribute__((address_space(3)))
typedef unsigned short bf16_t;
typedef short bf16x8 __attribute__((ext_vector_type(8)));
typedef float f32x4 __attribute__((ext_vector_type(4)));
typedef unsigned u32x4 __attribute__((ext_vector_type(4)));
constexpr int BM = 256, BK = 64, HALF = 128, HTB = HALF * BK * 2  , STAGE_BYTES = 8 * HTB, NXCD = 8, WGM = 8;

__host__ __device__ __forceinline__ int lds_byte(int r, int c) { const int st = (r >> 4) * 2 + (c >> 5), rr = r & 15, cc = c & 31, ob = rr * 64 + cc * 2; return st * 1024 + (ob ^ (((ob >> 9) & 1) << 5)); }
__host__ __device__ __forceinline__ void stage_rc(int b, int& R, int& C) { const int st = b / 1024, sb = b % 1024, swz = sb ^ (((sb >> 9) & 1) << 5); R = (st >> 1) * 16 + swz / 64; C = (st & 1) * 32 + (swz % 64) / 2; }
__host__ __device__ __forceinline__ int perm32(int rho) { const int n = rho >> 4, i = rho & 15; return 8 * (i >> 2) + 4 * n + (i & 3); }

struct Unit { int pm, pn; };
struct Gemm { const bf16_t* A; const bf16_t* Bt; int M, N, K; };

struct StaticOrder {
    int nM, nN, nwg, G, c;
    __host__ __device__ void init(int M, int N, int G_, int c_) { nM = M / BM; nN = N / BM; nwg = nM * nN; G = G_; c = c_; }
    __host__ __device__ bool next(int i, Unit& u) const {
        const long L = (long)i * G + c; if (L >= nwg) return false;
        int wgid = (int)L; { const int q = nwg / NXCD, r = nwg % NXCD, xcd = wgid % NXCD, off = wgid / NXCD; wgid = (xcd < r ? xcd * (q + 1) : r * (q + 1) + (xcd - r) * q) + off; }
        const int nig = WGM * nN, gid = wgid / nig, fm = gid * WGM, gsz = (nM - fm) < WGM ? (nM - fm) : WGM;
        u.pm = fm + ((wgid % nig) % gsz); u.pn = (wgid % nig) / gsz; return true;
    }
    __device__ __forceinline__ void a_ready(const Unit&) const {}
    __device__ __forceinline__ void done(const Unit&) const {}
};

__device__ __forceinline__ unsigned cvt_pk_bf16(float lo, float hi) { unsigned r; asm volatile("v_cvt_pk_bf16_f32 %0, %1, %2" : "=v"(r) : "v"(lo), "v"(hi)); return r; }
typedef float f32x2 __attribute__((ext_vector_type(2)));
template <class Epi, class Sched, bool ALIGN_EPI = false, bool SP2 = false>
__device__ __forceinline__ void gemm_phase(PG8_LAS unsigned char* lds, const Gemm g, const Sched& S, const Epi& E) {
    int tid = threadIdx.x; asm volatile("" : "+v"(tid));
    const int wid = __builtin_amdgcn_readfirstlane(tid >> 6), lane = tid & 63, wr = wid >> 2, wc = wid & 3, fr = lane & 15, fq = lane >> 4;
    const int K = g.K, nt = K / BK;
    unsigned voffA[2], voffB[2];
#pragma unroll
    for (int i = 0; i < 2; ++i) { int R, C; stage_rc(tid * 16 + i * 8192, R, C); const int Rb = Epi::PERM ? ((R & ~31) + perm32(R & 31)) : R;
        voffA[i] = (unsigned)(R * K + C) * 2u; voffB[i] = (unsigned)(Rb * K + C) * 2u; }
    const size_t kstep = (size_t)(BK * 2);
    const size_t hstep = (size_t)HALF * K * 2;
    const size_t tstep = 2 * hstep;
    const unsigned ldsw = (unsigned)wid * 1024u;
    const int aoff = lds_byte(wr * 64 + fr, fq * 8), boff = lds_byte(wc * 32 + fr, fq * 8);
#define PG8_SA(b, h) (((b) * 2 + (h)) * HTB)
#define PG8_SB(b, h) ((4 + (b) * 2 + (h)) * HTB)
#define PG8_STAGE(bufoff, gbase, voff) do { _Pragma("unroll") for (int _i = 0; _i < 2; ++_i) \
        __builtin_amdgcn_global_load_lds((const unsigned*)((const char*)(gbase) + (voff)[_i]), (PG8_LAS unsigned*)(lds + (bufoff) + ldsw + _i * 8192), 16, 0, 0); } while (0)
#define PG8_LDA(dst, b, h) do { _Pragma("unroll") for (int m = 0; m < 4; ++m) _Pragma("unroll") for (int k = 0; k < 2; ++k) dst[m][k] = *(const PG8_LAS bf16x8*)(lds + PG8_SA(b, h) + aoff + m * 2048 + k * 1024); } while (0)
#define PG8_LDB(dst, b, h) do { _Pragma("unroll") for (int n = 0; n < 2; ++n) _Pragma("unroll") for (int k = 0; k < 2; ++k) dst[n][k] = *(const PG8_LAS bf16x8*)(lds + PG8_SB(b, h) + boff + n * 2048 + k * 1024); } while (0)
#define PG8_MMA(ai, bj, At, Bt) do { __builtin_amdgcn_s_setprio(1); _Pragma("unroll") for (int m = 0; m < 4; ++m) _Pragma("unroll") for (int n = 0; n < 2; ++n) _Pragma("unroll") for (int k = 0; k < 2; ++k) \
        acc[ai][bj][m][n] = __builtin_amdgcn_mfma_f32_16x16x32_bf16(Bt[n][k], At[m][k], acc[ai][bj][m][n], 0, 0, 0); __builtin_amdgcn_s_setprio(0); } while (0)
#define PG8_WAIT_V(n) asm volatile("s_waitcnt vmcnt(" #n ")" ::: "memory")
#define PG8_WAIT_L(n) asm volatile("s_waitcnt lgkmcnt(" #n ")" ::: "memory")
#define PG8_BAR __builtin_amdgcn_s_barrier()
#define PG8_SCHED __builtin_amdgcn_sched_barrier(0)
    Unit cur, nxt; int ui = 0;
    if (!S.next(0, cur)) return;
    f32x4 acc[2][2][4][2];
#pragma unroll
    for (int a = 0; a < 2; ++a)
#pragma unroll
        for (int b = 0; b < 2; ++b)
#pragma unroll
            for (int m = 0; m < 4; ++m)
#pragma unroll
                for (int n = 0; n < 2; ++n) acc[a][b][m][n] = (f32x4){0.f, 0.f, 0.f, 0.f};
    bf16x8 At[4][2], B0[2][2], B1[2][2];
    const char* cA = (const char*)g.A + (size_t)cur.pm * tstep; const char* cB = (const char*)g.Bt + (size_t)cur.pn * tstep;
    S.a_ready(cur);
    if constexpr (SP2) {
        PG8_STAGE(PG8_SB(0, 0), cB, voffB); PG8_STAGE(PG8_SB(0, 1), cB + hstep, voffB); PG8_STAGE(PG8_SA(0, 0), cA, voffA); PG8_STAGE(PG8_SA(0, 1), cA + hstep, voffA);
        if (wr == 1) PG8_BAR;
        PG8_WAIT_V(2); PG8_BAR;
        PG8_STAGE(PG8_SB(1, 0), cB + kstep, voffB); PG8_STAGE(PG8_SA(1, 0), cA + kstep, voffA); PG8_STAGE(PG8_SB(1, 1), cB + hstep + kstep, voffB);
        PG8_WAIT_V(6); PG8_BAR;
    } else {
        PG8_STAGE(PG8_SB(0, 0), cB, voffB); PG8_STAGE(PG8_SA(0, 0), cA, voffA); PG8_STAGE(PG8_SB(0, 1), cB + hstep, voffB); PG8_STAGE(PG8_SA(0, 1), cA + hstep, voffA);
        if (wr == 1) PG8_BAR;
        PG8_WAIT_V(4); PG8_BAR;
        PG8_STAGE(PG8_SB(1, 0), cB + kstep, voffB); PG8_STAGE(PG8_SA(1, 0), cA + kstep, voffA); PG8_STAGE(PG8_SB(1, 1), cB + hstep + kstep, voffB);
        PG8_WAIT_V(6); PG8_BAR;
    }
    for (;;) {
        const bool has_next = S.next(ui + 1, nxt);
        const char* nA = has_next ? (const char*)g.A + (size_t)nxt.pm * tstep : cA; const char* nB = has_next ? (const char*)g.Bt + (size_t)nxt.pn * tstep : cB;
        for (int t = 0; t < nt; t += 2) {
            const bool last = (t == nt - 2);
            const char* a1 = cA + (size_t)(t + 1) * kstep;
            const char* a2 = last ? nA : cA + (size_t)(t + 2) * kstep; const char* b2 = last ? nB : cB + (size_t)(t + 2) * kstep;
            const char* a3 = a2 + kstep; const char* b3 = b2 + kstep;
            if (last && has_next) S.a_ready(nxt);
            if constexpr (SP2) {
            PG8_LDB(B0, 0, 0); PG8_LDB(B1, 0, 1); PG8_SCHED; PG8_LDA(At, 0, 0); PG8_STAGE(PG8_SA(1, 1), a1 + hstep, voffA);
            PG8_WAIT_V(8); PG8_WAIT_L(0); PG8_BAR; PG8_MMA(0, 0, At, B0); PG8_MMA(0, 1, At, B1); PG8_BAR; PG8_SCHED;
            PG8_LDA(At, 0, 1); PG8_STAGE(PG8_SB(0, 0), b2, voffB); PG8_STAGE(PG8_SB(0, 1), b2 + hstep, voffB); PG8_STAGE(PG8_SA(0, 0), a2, voffA);
            PG8_WAIT_V(8); PG8_WAIT_L(0); PG8_BAR; PG8_MMA(1, 0, At, B0); PG8_MMA(1, 1, At, B1); PG8_BAR; PG8_SCHED;
            PG8_LDB(B0, 1, 0); PG8_LDB(B1, 1, 1); PG8_SCHED; PG8_LDA(At, 1, 0); PG8_STAGE(PG8_SA(0, 1), a2 + hstep, voffA);
            PG8_WAIT_V(8); PG8_WAIT_L(0); PG8_BAR; PG8_MMA(0, 0, At, B0); PG8_MMA(0, 1, At, B1); PG8_BAR; PG8_SCHED;
            PG8_LDA(At, 1, 1); PG8_STAGE(PG8_SB(1, 0), b3, voffB); PG8_STAGE(PG8_SB(1, 1), b3 + hstep, voffB); PG8_STAGE(PG8_SA(1, 0), a3, voffA);
            PG8_WAIT_V(8); PG8_WAIT_L(0); PG8_BAR; PG8_MMA(1, 0, At, B0); PG8_MMA(1, 1, At, B1); PG8_BAR; PG8_SCHED;
            } else {
            PG8_LDB(B0, 0, 0); PG8_SCHED; PG8_LDA(At, 0, 0); PG8_STAGE(PG8_SA(1, 1), a1 + hstep, voffA);
            PG8_WAIT_L(8); PG8_BAR; PG8_WAIT_L(0); PG8_MMA(0, 0, At, B0); PG8_BAR; PG8_SCHED;
            PG8_LDB(B1, 0, 1); PG8_STAGE(PG8_SB(0, 0), b2, voffB);
            PG8_BAR; PG8_WAIT_L(0); PG8_MMA(0, 1, At, B1); PG8_BAR;
            PG8_LDA(At, 0, 1); PG8_STAGE(PG8_SA(0, 0), a2, voffA);
            PG8_BAR; PG8_WAIT_L(0); PG8_MMA(1, 0, At, B0); PG8_BAR; PG8_SCHED;
            PG8_STAGE(PG8_SB(0, 1), b2 + hstep, voffB);
            PG8_WAIT_V(6); PG8_BAR; PG8_MMA(1, 1, At, B1); PG8_BAR;
            PG8_LDB(B0, 1, 0); PG8_SCHED; PG8_LDA(At, 1, 0); PG8_STAGE(PG8_SA(0, 1), a2 + hstep, voffA);
            PG8_WAIT_L(8); PG8_BAR; PG8_WAIT_L(0); PG8_MMA(0, 0, At, B0); PG8_BAR; PG8_SCHED;
            PG8_LDB(B1, 1, 1); PG8_STAGE(PG8_SB(1, 0), b3, voffB);
            PG8_BAR; PG8_WAIT_L(0); PG8_MMA(0, 1, At, B1); PG8_BAR;
            PG8_LDA(At, 1, 1); PG8_STAGE(PG8_SA(1, 0), a3, voffA);
            PG8_BAR; PG8_WAIT_L(0); PG8_MMA(1, 0, At, B0); PG8_BAR; PG8_SCHED;
            PG8_STAGE(PG8_SB(1, 1), b3 + hstep, voffB);
            PG8_WAIT_V(6); PG8_BAR; PG8_MMA(1, 1, At, B1); PG8_BAR;
            }
        }
        if constexpr (ALIGN_EPI) { if (wr == 0) PG8_BAR; }
        if constexpr (!Epi::AFTER_DRAIN) { E(acc, cur, wr, wc, fr, fq); S.done(cur); }
        if (!has_next) break;
#pragma unroll
        for (int a = 0; a < 2; ++a)
#pragma unroll
            for (int b = 0; b < 2; ++b)
#pragma unroll
                for (int m = 0; m < 4; ++m)
#pragma unroll
                    for (int n = 0; n < 2; ++n) acc[a][b][m][n] = (f32x4){0.f, 0.f, 0.f, 0.f};
        cur = nxt; cA = nA; cB = nB; ++ui;
        if constexpr (ALIGN_EPI) { if (wr == 1) PG8_BAR; }
    }
    PG8_WAIT_V(0);
    if constexpr (!ALIGN_EPI) { if (wr == 0) PG8_BAR; }
    PG8_BAR;
    if constexpr (Epi::AFTER_DRAIN) { E.fused(acc, cur, wr, wc, fr, fq, lds, wid, lane); S.done(cur); }
#undef PG8_SA
#undef PG8_SB
#undef PG8_STAGE
#undef PG8_LDA
#undef PG8_LDB
#undef PG8_MMA
#undef PG8_WAIT_V
#undef PG8_WAIT_L
#undef PG8_BAR
#undef PG8_SCHED
}
}
#define GAS __attribute__((address_space(1)))
#define LAS __attribute__((address_space(3)))
typedef unsigned short bf16;
typedef unsigned v4u __attribute__((ext_vector_type(4)));
typedef float f32x4 __attribute__((ext_vector_type(4)));
typedef short bf16x8 __attribute__((ext_vector_type(8)));
typedef GAS unsigned gu32;
typedef GAS unsigned long long gu64;
#define RLX_AGENT __ATOMIC_RELAXED, __HIP_MEMORY_SCOPE_AGENT
#define LDS_WAIT() asm volatile("s_waitcnt lgkmcnt(0)" ::: "memory")
#define VM_WAIT() asm volatile("s_waitcnt vmcnt(0)" ::: "memory")
__device__ __forceinline__ unsigned long long rt() { return __builtin_amdgcn_s_memrealtime(); }
__device__ __forceinline__ unsigned f2bf(float f) { unsigned u = __builtin_bit_cast(unsigned, f); return (u + 0x7fffu + ((u >> 16) & 1u)) >> 16; }
__device__ __forceinline__ unsigned pk2(float lo, float hi) { return f2bf(lo) | (f2bf(hi) << 16); }

#define XB_TMO      128
#define XB_XCNT(j)  (256  + 64 * (j))
#define XB_XSUB(j)  (1280 + 64 * (j))
#define XB_XGEN(j)  (2304 + 64 * (j))
#define XB_TOP      3328
#define XB_TOPGEN   3392
#define XCD_BAR_WORDS 3456
#define XB_SPIN_CAP (1u << 18)

__device__ __forceinline__ unsigned xb_ld(unsigned* p)              { return __hip_atomic_load(p, __ATOMIC_RELAXED, __HIP_MEMORY_SCOPE_AGENT); }
__device__ __forceinline__ unsigned xb_add(unsigned* p, unsigned v) { return __hip_atomic_fetch_add(p, v, __ATOMIC_RELAXED, __HIP_MEMORY_SCOPE_AGENT); }
__device__ __forceinline__ unsigned xb_xcc_id() { return (unsigned)__builtin_amdgcn_s_getreg((3 << 11) | 20) & 0xFu; }
#define XB_SPIN(cond, bar) do { unsigned _sp = 0; while (cond) { __builtin_amdgcn_s_sleep(1); \
    if ((++_sp & 255u) == 0u) { if (xb_ld(&(bar)[XB_TMO])) break; if (_sp > XB_SPIN_CAP) { atomicAdd(&(bar)[XB_TMO], 1u); break; } } } } while (0)

struct XcdBarrier {
    unsigned* bar; unsigned x;
    volatile LAS unsigned* st;
};

__device__ __forceinline__ XcdBarrier xcd_barrier_post(unsigned* bar, volatile LAS unsigned* st) {
    XcdBarrier b; b.bar = bar; b.x = xb_xcc_id(); b.st = st;
    if (threadIdx.x == 0) (void)xb_add(&bar[XB_XCNT(b.x)], 1u);
    return b;
}
__device__ __forceinline__ void xcd_barrier_complete(unsigned* bar, unsigned x, unsigned& nloc, unsigned& nx) {
    const unsigned G = gridDim.x * gridDim.y * gridDim.z;
    unsigned sum, cnt, mine, sp = 0u;
    for (;;) {
        sum = 0u; cnt = 0u; mine = 0u;
#pragma unroll
        for (unsigned j = 0; j < 16; ++j) { const unsigned c = xb_ld(&bar[XB_XCNT(j)]); sum += c; cnt += (c > 0u) ? 1u : 0u; mine = (j == x) ? c : mine; }
        if (sum == G) break;
        __builtin_amdgcn_s_sleep(1);
        if ((++sp & 255u) == 0u) { if (xb_ld(&bar[XB_TMO])) break; if (sp > XB_SPIN_CAP) { atomicAdd(&bar[XB_TMO], 1u); break; } }
    }
    nloc = mine > 0u ? mine : 1u; nx = cnt > 0u ? cnt : 1u;
}

__device__ __forceinline__ void xcd_barrier(const XcdBarrier& b) {
    asm volatile("s_waitcnt vmcnt(0)" ::: "memory");
    __syncthreads();
    if (threadIdx.x == 0) {
        unsigned* bar = b.bar;
        __builtin_amdgcn_s_waitcnt(0);
        unsigned nloc = b.st[0], nx = b.st[1];
        if (nloc == 0u) { xcd_barrier_complete(bar, b.x, nloc, nx); b.st[0] = nloc; b.st[1] = nx; }
        const unsigned old = xb_add(&bar[XB_XSUB(b.x)], 1u);
        const unsigned gen = old / nloc;
        if (old + 1u == (gen + 1u) * nloc) {
            __builtin_amdgcn_fence(__ATOMIC_RELEASE, "agent");
            asm volatile("s_waitcnt vmcnt(0)" ::: "memory");
            const unsigned og = xb_add(&bar[XB_TOP], 1u);
            const unsigned tg = og / nx;
            if (og + 1u == (tg + 1u) * nx) xb_add(&bar[XB_TOPGEN], 1u);
            else XB_SPIN(xb_ld(&bar[XB_TOPGEN]) == tg, bar);
            __builtin_amdgcn_fence(__ATOMIC_ACQUIRE, "agent");
            xb_add(&bar[XB_XGEN(b.x)], 1u);
            asm volatile("s_waitcnt vmcnt(0)" ::: "memory");
        } else {
            XB_SPIN(xb_ld(&bar[XB_XGEN(b.x)]) == gen, bar);
            __builtin_amdgcn_fence(__ATOMIC_ACQUIRE, "agent");
            asm volatile("s_waitcnt vmcnt(0)" ::: "memory");
        }
    }
    __syncthreads();
}

constexpr int D = 1024, MP = 16384, MS = 2048, M = MP + MS, DFF = 2816, NUP = 2 * DFF, DIN = 3072, NSEQ = 40, NMOD = 9216;
constexpr int NWAVES = 8, NTHREADS = 512;
constexpr float EPS = 1e-6f;
constexpr float C2 = 0.125f * 1.4426950408889634f;
constexpr size_t O_YP = 0, O_YS = 16777216, O_KP = 18874368, O_VP = 35651584, O_SP = 52428800, O_KS = 52953088, O_VS = 55050240, O_SS = 57147392;
constexpr size_t MiB = 1u << 20;
constexpr size_t WS_CTL = 0, CTL_ZERO_BYTES = 1 * MiB;
constexpr size_t WS_MOD = 1 * MiB;
constexpr size_t WS_TRIG = 4 * MiB;
constexpr size_t WS_WUP = 8 * MiB;
constexpr size_t WS_WDN = 52 * MiB;
constexpr size_t WS_WIN = 74 * MiB;
constexpr size_t WS_WOUT = 86 * MiB;
constexpr size_t WS_H = 90 * MiB;
constexpr size_t WS_ACT = 126 * MiB;
constexpr size_t WS_MIX = 225 * MiB;
constexpr size_t WS_RQ = 261 * MiB;
constexpr size_t WS_RK = 270 * MiB;
constexpr size_t WS_RV = 279 * MiB;
constexpr size_t WS_SG = 297 * MiB;
constexpr size_t WS_DQ = 315 * MiB;
constexpr size_t WS_DK = 333 * MiB;
constexpr size_t WS_DV = 351 * MiB;
constexpr size_t WS_KV = 369 * MiB;
constexpr size_t WS_SC = 405 * MiB;
constexpr size_t WS_PART = 423 * MiB;
constexpr size_t WS_END = 460 * MiB;
constexpr int CW_BAR = 4096;
constexpr int RING_BYTES = 131072, MISC_OFF = RING_BYTES + 320, LDS_BYTES = 147456;

using pg8::Unit; using pg8::u32x4; using pg8::bf16_t;
typedef short s16x4 __attribute__((ext_vector_type(4)));
typedef float f32x16 __attribute__((ext_vector_type(16)));
typedef float f32x2v __attribute__((ext_vector_type(2)));
typedef __bf16 bf16x2_t __attribute__((ext_vector_type(2)));

__device__ __forceinline__ unsigned cvtpk(float lo, float hi) { f32x2v v = {lo, hi}; bf16x2_t b = __builtin_convertvector(v, bf16x2_t); return __builtin_bit_cast(unsigned, b); }
__device__ __forceinline__ float bf2f(unsigned short b) { return __builtin_bit_cast(float, (unsigned)b << 16); }
__device__ __forceinline__ float silu_f(float a) { return a * __builtin_amdgcn_rcpf(1.0f + __builtin_amdgcn_exp2f(-1.4426950408889634f * a)); }
__device__ __forceinline__ int row_sidx(int r) { return r < MP ? (r >> 11) : 8 + ((r - MP) >> 6); }
__device__ __forceinline__ int row_tidx(int r) { return r < MP ? (r & 2047) : 2048 + (r & 63); }
__device__ __forceinline__ float wave_sum(float v) {
#pragma unroll
    for (int o = 1; o < 64; o <<= 1) v += __shfl_xor(v, o);
    return v;
}
__device__ __forceinline__ float wave_max(float v) {
#pragma unroll
    for (int o = 1; o < 64; o <<= 1) v = fmaxf(v, __shfl_xor(v, o));
    return v;
}
__device__ __forceinline__ unsigned off_b(unsigned row, unsigned ch) { return 256u * row + 16u * (ch ^ (((row & 3u) << 2) | ((row >> 2) & 3u))); }
__device__ __forceinline__ unsigned tr_addr(unsigned lane, unsigned R0, unsigned c) {
    const unsigned blk = (lane >> 4) & 1u, q = (lane & 15u) >> 2, p = lane & 3u;
    return off_b(R0 + q, 4u * c + 2u * blk + (p >> 1)) + 8u * (p & 1u);
}
__device__ __forceinline__ s16x4 ds_tr(LAS unsigned char* base, unsigned off) {
    return __builtin_bit_cast(s16x4, __builtin_amdgcn_ds_read_tr16_b64_v4i16((LAS s16x4*)(base + off)));
}
__device__ __forceinline__ bf16x8 cat8(s16x4 lo, s16x4 hi) { return (bf16x8){lo[0], lo[1], lo[2], lo[3], hi[0], hi[1], hi[2], hi[3]}; }
#define MFMA32(a, b, c) __builtin_amdgcn_mfma_f32_32x32x16_bf16((a), (b), (c), 0, 0, 0)
__device__ __forceinline__ int crow(int r, int hi) { return (r & 3) + 8 * (r >> 2) + 4 * hi; }
__device__ __forceinline__ bf16x8 pack_step(const f32x16& x, int s) {
    u32x4 p; p[0] = cvtpk(x[8 * s], x[8 * s + 1]); p[1] = cvtpk(x[8 * s + 2], x[8 * s + 3]); p[2] = cvtpk(x[8 * s + 4], x[8 * s + 5]); p[3] = cvtpk(x[8 * s + 6], x[8 * s + 7]);
    return __builtin_bit_cast(bf16x8, p);
}

struct EpiUp {
    static constexpr bool PERM = true, AFTER_DRAIN = false;
    bf16_t* act;
    __device__ __forceinline__ void operator()(const f32x4 (&acc)[2][2][4][2], const Unit& u, int wr, int wc, int fr, int fq) const {
        asm volatile("" : "+v"(fr), "+v"(fq));
        const int row0 = u.pm * 256 + wr * 64 + fr, col = u.pn * 128 + wc * 32 + 8 * fq;
#pragma unroll
        for (int ai = 0; ai < 2; ++ai)
#pragma unroll
            for (int m = 0; m < 4; ++m) {
                const int row = row0 + ai * 128 + m * 16;
                float o[8];
#pragma unroll
                for (int n = 0; n < 2; ++n)
#pragma unroll
                    for (int e = 0; e < 4; ++e) o[4 * n + e] = silu_f(acc[ai][0][m][n][e]) * acc[ai][1][m][n][e];
                u32x4 w; w.x = cvtpk(o[0], o[1]); w.y = cvtpk(o[2], o[3]); w.z = cvtpk(o[4], o[5]); w.w = cvtpk(o[6], o[7]);
                *(u32x4*)(act + (size_t)row * DFF + col) = w;
                asm volatile("" ::: "memory");
            }
    }
};
struct EpiRes {
    static constexpr bool PERM = false, AFTER_DRAIN = false;
    const float* xin_p; const float* xin_s; float* xout; const float* gate; float fac;
    __device__ __forceinline__ void operator()(const f32x4 (&acc)[2][2][4][2], const Unit& u, int wr, int wc, int fr, int fq) const {
        asm volatile("" : "+v"(fr), "+v"(fq));
        const int row0 = u.pm * 256 + wr * 64 + fr, col0 = u.pn * 256 + wc * 32 + 4 * fq;
#pragma unroll
        for (int ai = 0; ai < 2; ++ai)
#pragma unroll
            for (int m = 0; m < 4; ++m) {
                const int row = row0 + ai * 128 + m * 16;
                const float* g = gate + (size_t)row_sidx(row) * NMOD + col0;
                const float* xi = (row < MP ? xin_p + (size_t)row * D : xin_s + (size_t)(row - MP) * D) + col0;
                float* xo = xout + (size_t)row * D + col0;
#pragma unroll
                for (int bj = 0; bj < 2; ++bj)
#pragma unroll
                    for (int n = 0; n < 2; ++n) {
                        const int c = bj * 128 + n * 16;
                        const f32x4 gv = *(const f32x4*)(g + c), xv = *(const f32x4*)(xi + c);
                        *(f32x4*)(xo + c) = xv + (gv * fac) * acc[ai][bj][m][n];
                    }
                asm volatile("" ::: "memory");
            }
    }
};
struct EpiIn {
    static constexpr bool PERM = true, AFTER_DRAIN = false;
    bf16_t *RQ, *RK, *RV, *SG, *DQ, *DK, *DV; float *kout_p, *kout_s, *vout_p, *vout_s;
    const float* trig; const float* gqk;
    __device__ __forceinline__ void operator()(const f32x4 (&acc)[2][2][4][2], const Unit& u, int wr, int wc, int fr, int fq) const {
        asm volatile("" : "+v"(fr), "+v"(fq));
        const int row0 = u.pm * 256 + wr * 64 + fr; const int pn = u.pn;
        if (pn <= 1) {
            bf16_t* O = pn == 0 ? RQ : RK;
#pragma unroll
            for (int bj = 0; bj < 2; ++bj) {
                const int head = 2 * bj + (wc >> 1);
                const float lg = log2f(1.0f - exp2f(-5.0f - (float)head));
                const int i0 = 16 * (wc & 1) + 4 * fq;
                const int colt = 128 * bj + 32 * wc + 8 * fq;
#pragma unroll
                for (int ai = 0; ai < 2; ++ai)
#pragma unroll
                    for (int m = 0; m < 4; ++m) {
                        const int row = row0 + ai * 128 + m * 16;
                        const float* tp = trig + ((size_t)row_tidx(row) * 2 + 0) * 64 + 2 * i0;
                        const f32x4 t0 = *(const f32x4*)tp, t1 = *(const f32x4*)(tp + 4);
                        const float ic1 = (float)((row & 63) + 1);
                        const float sc = pn == 0 ? exp2f(lg * ic1) : 0.125f * exp2f(-lg * ic1);
                        const f32x4 v0 = acc[ai][bj][m][0], v1 = acc[ai][bj][m][1];
                        float o[8];
                        o[0] = (v0[0] * t0[0] - v0[1] * t0[1]) * sc; o[1] = (v0[0] * t0[1] + v0[1] * t0[0]) * sc;
                        o[2] = (v0[2] * t0[2] - v0[3] * t0[3]) * sc; o[3] = (v0[2] * t0[3] + v0[3] * t0[2]) * sc;
                        o[4] = (v1[0] * t1[0] - v1[1] * t1[1]) * sc; o[5] = (v1[0] * t1[1] + v1[1] * t1[0]) * sc;
                        o[6] = (v1[2] * t1[2] - v1[3] * t1[3]) * sc; o[7] = (v1[2] * t1[3] + v1[3] * t1[2]) * sc;
                        u32x4 w; w.x = cvtpk(o[0], o[1]); w.y = cvtpk(o[2], o[3]); w.z = cvtpk(o[4], o[5]); w.w = cvtpk(o[6], o[7]);
                        *(u32x4*)(O + (size_t)row * 256 + colt) = w;
                        asm volatile("" ::: "memory");
                    }
            }
        } else if (pn <= 5) {
            bf16_t* O = pn <= 3 ? RV : SG; const int cb = 256 * ((pn - 2) & 1);
#pragma unroll
            for (int ai = 0; ai < 2; ++ai)
#pragma unroll
                for (int m = 0; m < 4; ++m) {
                    const int row = row0 + ai * 128 + m * 16;
#pragma unroll
                    for (int bj = 0; bj < 2; ++bj) {
                        f32x4 v0 = acc[ai][bj][m][0], v1 = acc[ai][bj][m][1];
                        if (pn >= 4) {
#pragma unroll
                            for (int e = 0; e < 4; ++e) { v0[e] = silu_f(v0[e]); v1[e] = silu_f(v1[e]); }
                        }
                        u32x4 w; w.x = cvtpk(v0[0], v0[1]); w.y = cvtpk(v0[2], v0[3]); w.z = cvtpk(v1[0], v1[1]); w.w = cvtpk(v1[2], v1[3]);
                        *(u32x4*)(O + (size_t)row * 512 + cb + 128 * bj + 32 * wc + 8 * fq) = w;
                    }
                    asm volatile("" ::: "memory");
                }
        } else if (pn <= 9) {
            const bool isq = pn <= 7; const int cb = 256 * ((pn - 6) & 1) + 64 * wc;
            const float* g = gqk + (isq ? 0 : 64);
            const f32x4 g00 = *(const f32x4*)(g + 8 * fq), g01 = *(const f32x4*)(g + 8 * fq + 4), g10 = *(const f32x4*)(g + 32 + 8 * fq), g11 = *(const f32x4*)(g + 32 + 8 * fq + 4);
#pragma unroll
            for (int ai = 0; ai < 2; ++ai)
#pragma unroll
                for (int m = 0; m < 4; ++m) {
                    const int row = row0 + ai * 128 + m * 16;
                    const f32x4 a0 = acc[ai][0][m][0], a1 = acc[ai][0][m][1], b0 = acc[ai][1][m][0], b1 = acc[ai][1][m][1];
                    float ss = 0.f;
#pragma unroll
                    for (int e = 0; e < 4; ++e) ss += a0[e] * a0[e] + a1[e] * a1[e] + b0[e] * b0[e] + b1[e] * b1[e];
                    ss += __shfl_xor(ss, 16); ss += __shfl_xor(ss, 32);
                    float rs = 1.0f / sqrtf(ss * (1.0f / 64.0f) + EPS);
                    const float* tp = trig + ((size_t)row_tidx(row) * 2 + 1) * 64 + 16 * fq;
                    const f32x4 t0 = *(const f32x4*)tp, t1 = *(const f32x4*)(tp + 4), t2 = *(const f32x4*)(tp + 8), t3 = *(const f32x4*)(tp + 12);
                    const float cs[8] = {t0[0], t0[2], t1[0], t1[2], t2[0], t2[2], t3[0], t3[2]}, sn[8] = {t0[1], t0[3], t1[1], t1[3], t2[1], t2[3], t3[1], t3[3]};
                    float x1[8], x2[8], o1[8], o2[8];
#pragma unroll
                    for (int e = 0; e < 4; ++e) { x1[e] = a0[e] * rs * g00[e]; x1[4 + e] = a1[e] * rs * g01[e]; x2[e] = b0[e] * rs * g10[e]; x2[4 + e] = b1[e] * rs * g11[e]; }
                    const float osc = isq ? C2 : 1.0f;
#pragma unroll
                    for (int j = 0; j < 8; ++j) { o1[j] = (x1[j] * cs[j] - x2[j] * sn[j]) * osc; o2[j] = (x2[j] * cs[j] + x1[j] * sn[j]) * osc; }
                    bf16_t* O = (isq ? DQ : DK) + (size_t)row * 512 + cb + 8 * fq;
                    u32x4 w; w.x = cvtpk(o1[0], o1[1]); w.y = cvtpk(o1[2], o1[3]); w.z = cvtpk(o1[4], o1[5]); w.w = cvtpk(o1[6], o1[7]);
                    *(u32x4*)O = w;
                    w.x = cvtpk(o2[0], o2[1]); w.y = cvtpk(o2[2], o2[3]); w.z = cvtpk(o2[4], o2[5]); w.w = cvtpk(o2[6], o2[7]);
                    *(u32x4*)(O + 32) = w;
                    if (!isq) {
                        float* ko = (row < MP ? kout_p + (size_t)row * 512 : kout_s + (size_t)(row - MP) * 512) + cb + 8 * fq;
                        *(f32x4*)ko = (f32x4){o1[0], o1[1], o1[2], o1[3]}; *(f32x4*)(ko + 4) = (f32x4){o1[4], o1[5], o1[6], o1[7]};
                        *(f32x4*)(ko + 32) = (f32x4){o2[0], o2[1], o2[2], o2[3]}; *(f32x4*)(ko + 36) = (f32x4){o2[4], o2[5], o2[6], o2[7]};
                    }
                    asm volatile("" ::: "memory");
                }
        } else {
            const int cb = 256 * ((pn - 10) & 1);
#pragma unroll
            for (int ai = 0; ai < 2; ++ai)
#pragma unroll
                for (int m = 0; m < 4; ++m) {
                    const int row = row0 + ai * 128 + m * 16;
                    float* vo = (row < MP ? vout_p + (size_t)row * 512 : vout_s + (size_t)(row - MP) * 512) + cb;
#pragma unroll
                    for (int bj = 0; bj < 2; ++bj) {
                        const int c = 128 * bj + 32 * wc + 8 * fq;
                        const f32x4 v0 = acc[ai][bj][m][0], v1 = acc[ai][bj][m][1];
                        *(f32x4*)(vo + c) = v0; *(f32x4*)(vo + c + 4) = v1;
                        u32x4 w; w.x = cvtpk(v0[0], v0[1]); w.y = cvtpk(v0[2], v0[3]); w.z = cvtpk(v1[0], v1[1]); w.w = cvtpk(v1[2], v1[3]);
                        *(u32x4*)(DV + (size_t)row * 512 + cb + c) = w;
                    }
                    asm volatile("" ::: "memory");
                }
        }
    }
};

__device__ __forceinline__ void transpose_item(const float* W, int K, int N, bf16_t* WT, int dst_row0, int src_col0, int k0, LAS float* scr, int lane) {
#pragma unroll 8
    for (int i = 0; i < 32; ++i) { const int kk = 2 * i + (lane >> 5); scr[kk * 33 + (lane & 31)] = W[(size_t)(k0 + kk) * N + src_col0 + (lane & 31)]; }
    LDS_WAIT(); asm volatile("" ::: "memory");
    const int c = lane & 7;
#pragma unroll
    for (int j = 0; j < 4; ++j) { const int n = (lane >> 3) + 8 * j; const LAS float* s = scr + (8 * c) * 33 + n;
        v4u o; o.x = pk2(s[0 * 33], s[1 * 33]); o.y = pk2(s[2 * 33], s[3 * 33]); o.z = pk2(s[4 * 33], s[5 * 33]); o.w = pk2(s[6 * 33], s[7 * 33]);
        *(GAS v4u*)(WT + (size_t)(dst_row0 + n) * K + k0 + 8 * c) = o; }
    LDS_WAIT(); asm volatile("" ::: "memory");
}
__device__ __forceinline__ void adaln_item(int item, const float* cp, const float* cs, const float* w_ada, const float* b_ada, float* mod, LAS unsigned char* lds, int tid, int wid, int lane) {
    const int l = item / 144, cg = item % 144, n = cg * 64 + lane;
    LAS float* T = (LAS float*)(lds + wid * 10240);
    float acc[40];
#pragma unroll
    for (int s = 0; s < 40; ++s) acc[s] = 0.f;
    const float* W = w_ada + (size_t)l * D * NMOD + n;
    for (int half = 0; half < 2; ++half) {
        const int kb = wid * 128 + half * 64;
#pragma unroll 8
        for (int s = 0; s < 40; ++s) { const float c = s < 8 ? cp[s * D + kb + lane] : cs[(s - 8) * D + kb + lane]; T[lane * 40 + s] = c / (1.0f + __expf(-c)); }
        LDS_WAIT(); asm volatile("" ::: "memory");
#pragma unroll 4
        for (int kk = 0; kk < 64; ++kk) {
            const float w = W[(size_t)(kb + kk) * NMOD];
#pragma unroll
            for (int s4 = 0; s4 < 10; ++s4) { const f32x4 t = *(const LAS f32x4*)(T + kk * 40 + 4 * s4);
                acc[4 * s4] += t[0] * w; acc[4 * s4 + 1] += t[1] * w; acc[4 * s4 + 2] += t[2] * w; acc[4 * s4 + 3] += t[3] * w; }
        }
        LDS_WAIT(); asm volatile("" ::: "memory");
    }
    __syncthreads();
    LAS float* R = (LAS float*)lds;
#pragma unroll
    for (int s = 0; s < 40; ++s) R[(wid * 40 + s) * 64 + lane] = acc[s];
    __syncthreads();
    for (int idx = tid; idx < 40 * 64; idx += NTHREADS) {
        const int s = idx >> 6, ln = idx & 63; float v = b_ada[(size_t)l * NMOD + cg * 64 + ln];
#pragma unroll
        for (int w = 0; w < 8; ++w) v += R[(w * 40 + s) * 64 + ln];
        mod[((size_t)l * NSEQ + s) * NMOD + cg * 64 + ln] = v;
    }
    __syncthreads();
}
__device__ __forceinline__ void trig_fill(float* trig, int gtid, int gthreads) {
    for (int i = gtid; i < 2112 * 64; i += gthreads) {
        const int pidx = i >> 6, kind = (i >> 5) & 1, j = i & 31;
        const int pos = pidx < 2048 ? pidx : 4096 + (pidx - 2048);
        const double ex = kind == 0 ? (double)j / 31.0 : (double)j / 32.0;
        const float invf = (float)exp2(-ex * 13.287712379549449);
        const float ang = (float)pos * invf;
        const double rev = (double)ang * 0.15915494309189535; const float fr = (float)(rev - floor(rev));
        trig[2 * i] = __builtin_amdgcn_cosf(fr); trig[2 * i + 1] = __builtin_amdgcn_sinf(fr);
    }
}
__device__ __forceinline__ void norm_phase(const float* xp, const float* xs, const float* g, const float* mod_l, int sub, bf16_t* H, int gw, int ngw, int lane) {
    for (int r = gw; r < M; r += ngw) {
        const float* xr = r < MP ? xp + (size_t)r * D : xs + (size_t)(r - MP) * D;
        const float* md = mod_l + (size_t)row_sidx(r) * NMOD + sub * 3 * D;
        f32x4 v[4]; float ss = 0.f;
#pragma unroll
        for (int j = 0; j < 4; ++j) { v[j] = *(const f32x4*)(xr + 4 * lane + 256 * j); ss += (v[j][0] * v[j][0] + v[j][1] * v[j][1]) + (v[j][2] * v[j][2] + v[j][3] * v[j][3]); }
        const float rs = 1.0f / sqrtf(wave_sum(ss) * (1.0f / D) + EPS);
#pragma unroll
        for (int j = 0; j < 4; ++j) {
            const int c = 4 * lane + 256 * j;
            const f32x4 gv = *(const f32x4*)(g + c), sh = *(const f32x4*)(md + c), sc = *(const f32x4*)(md + D + c);
            const f32x4 y = (v[j] * rs) * gv * (sc + 1.0f) + sh;
            unsigned long long o = (unsigned long long)cvtpk(y[0], y[1]) | ((unsigned long long)cvtpk(y[2], y[3]) << 32);
            *(unsigned long long*)(H + (size_t)r * D + c) = o;
        }
    }
}

__device__ __forceinline__ int unit_row0(int u) { return u < 1024 ? ((u >> 7) * 2048 + (u & 31) * 64) : MP + ((u - 1024) >> 2) * 64; }
__device__ __forceinline__ int unit_head(int u) { return u < 1024 ? ((u >> 5) & 3) : (u & 3); }
__device__ __forceinline__ void stage_tile_wave(const bf16_t* src, int row0, int pitch, int col0, LAS unsigned char* img, int lane) {
#pragma unroll
    for (int i = 0; i < 16; ++i) { const int n = lane + 64 * i, row = n >> 4, ch = n & 15;
        const u32x4 v = *(const u32x4*)(src + (size_t)(row0 + row) * pitch + col0 + ch * 8);
        *(LAS u32x4*)(img + off_b(row, ch)) = v; }
}
__device__ __forceinline__ void ret_kv_item(int item, const bf16_t* RK, const bf16_t* RV, float* KV, LAS unsigned char* img, int lane) {
    const int u = item >> 1, dt = item & 1, r0 = unit_row0(u), h = unit_head(u), hi = lane >> 5, l32 = lane & 31;
    stage_tile_wave(RV, r0, 512, h * 128, img, lane);
    bf16x8 ka[4];
#pragma unroll
    for (int s = 0; s < 4; ++s)
#pragma unroll
        for (int j = 0; j < 8; ++j) ka[s][j] = (short)RK[(size_t)(r0 + 16 * s + 8 * hi + j) * 256 + h * 64 + 32 * dt + l32];
    LDS_WAIT(); asm volatile("" ::: "memory");
    f32x16 acc[4];
#pragma unroll
    for (int et = 0; et < 4; ++et) {
        acc[et] = (f32x16){};
#pragma unroll
        for (int s = 0; s < 4; ++s) {
            const bf16x8 vb = cat8(ds_tr(img, tr_addr(lane, 16 * s + 8 * hi, et)), ds_tr(img, tr_addr(lane, 16 * s + 8 * hi + 4, et)));
            acc[et] = MFMA32(ka[s], vb, acc[et]);
        }
    }
    float* o = KV + (size_t)u * 8192;
#pragma unroll
    for (int et = 0; et < 4; ++et)
#pragma unroll
        for (int r = 0; r < 16; ++r) o[(32 * dt + crow(r, hi)) * 128 + 32 * et + l32] = acc[et][r];
    LDS_WAIT(); asm volatile("" ::: "memory");
}
__device__ __forceinline__ void ret_out_item(int item, const bf16_t* RQ, const bf16_t* RK, const bf16_t* RV, const bf16_t* SG, const bf16_t* SC, bf16_t* MIX, LAS unsigned char* img, int lane) {
    const int u = item >> 1, it = item & 1, r0 = unit_row0(u), h = unit_head(u), hi = lane >> 5, l32 = lane & 31;
    stage_tile_wave(SC + (size_t)u * 8192, 0, 128, 0, img, lane);
    bf16x8 qf[4];
#pragma unroll
    for (int s = 0; s < 4; ++s) qf[s] = *(const bf16x8*)(RQ + (size_t)(r0 + 32 * it + l32) * 256 + h * 64 + 16 * s + 8 * hi);
    LDS_WAIT(); asm volatile("" ::: "memory");
    f32x16 o[4];
#pragma unroll
    for (int et = 0; et < 4; ++et) {
        o[et] = (f32x16){};
#pragma unroll
        for (int s = 0; s < 4; ++s) {
            const bf16x8 sa = cat8(ds_tr(img, tr_addr(lane, 16 * s + 8 * hi, et)), ds_tr(img, tr_addr(lane, 16 * s + 8 * hi + 4, et)));
            o[et] = MFMA32(sa, qf[s], o[et]);
        }
    }
    LDS_WAIT(); asm volatile("" ::: "memory");
    stage_tile_wave(RV, r0, 512, h * 128, img, lane);
    f32x16 p[2];
#pragma unroll
    for (int jt = 0; jt < 2; ++jt) {
        p[jt] = (f32x16){};
        if (jt <= it) {
#pragma unroll
            for (int s = 0; s < 4; ++s) {
                const bf16x8 kf = *(const bf16x8*)(RK + (size_t)(r0 + 32 * jt + l32) * 256 + h * 64 + 16 * s + 8 * hi);
                p[jt] = MFMA32(kf, qf[s], p[jt]);
            }
            if (jt == it) {
#pragma unroll
                for (int r = 0; r < 16; ++r) if (crow(r, hi) > l32) p[jt][r] = 0.f;
            }
        }
    }
    LDS_WAIT(); asm volatile("" ::: "memory");
#pragma unroll
    for (int jt = 0; jt < 2; ++jt) {
        if (jt <= it) {
#pragma unroll
            for (int s2 = 0; s2 < 2; ++s2) {
                const bf16x8 xb = pack_step(p[jt], s2);
#pragma unroll
                for (int et = 0; et < 4; ++et) {
                    const bf16x8 va = cat8(ds_tr(img, tr_addr(lane, 32 * jt + 16 * s2 + 4 * hi, et)), ds_tr(img, tr_addr(lane, 32 * jt + 16 * s2 + 8 + 4 * hi, et)));
                    o[et] = MFMA32(va, xb, o[et]);
                }
            }
        }
    }
    float ss = 0.f;
#pragma unroll
    for (int et = 0; et < 4; ++et)
#pragma unroll
        for (int r = 0; r < 16; ++r) ss += o[et][r] * o[et][r];
    ss += __shfl_xor(ss, 32);
    const float rs = 1.0f / sqrtf(ss * (1.0f / 128.0f) + EPS);
    const size_t row = (size_t)(r0 + 32 * it + l32);
#pragma unroll
    for (int et = 0; et < 4; ++et)
#pragma unroll
        for (int rg = 0; rg < 4; ++rg) {
            const int e = 32 * et + 8 * rg + 4 * hi;
            const unsigned long long gq = *(const unsigned long long*)(SG + row * 512 + h * 128 + e);
            const float g0 = bf2f((unsigned short)gq), g1 = bf2f((unsigned short)(gq >> 16)), g2 = bf2f((unsigned short)(gq >> 32)), g3 = bf2f((unsigned short)(gq >> 48));
            const unsigned long long w = (unsigned long long)cvtpk(o[et][4 * rg] * rs * g0, o[et][4 * rg + 1] * rs * g1) | ((unsigned long long)cvtpk(o[et][4 * rg + 2] * rs * g2, o[et][4 * rg + 3] * rs * g3) << 32);
            *(unsigned long long*)(MIX + row * D + h * 128 + e) = w;
        }
    LDS_WAIT(); asm volatile("" ::: "memory");
}
__device__ __forceinline__ void scan_phase(const float* KV, bf16_t* SC, const float* state_l, float* sp_l, float* ss_l, int gtid, int gthreads) {
    for (int i = gtid; i < 32 * 4096; i += gthreads) {
        const int bh = i >> 12, pr = i & 4095, h = bh & 3;
        const float g64 = exp2f(64.0f * log2f(1.0f - exp2f(-5.0f - (float)h)));
        f32x2v S = {0.f, 0.f};
        for (int c = 0; c < 32; ++c) {
            const size_t u = (size_t)bh * 32 + c;
            const f32x2v kv = *(const f32x2v*)(KV + u * 8192 + 2 * pr);
            *(unsigned*)(SC + u * 8192 + 2 * pr) = cvtpk(S[0], S[1]);
            S = (S + kv) * g64;
        }
        *(f32x2v*)(sp_l + (size_t)bh * 8192 + 2 * pr) = S;
    }
    for (int i = gtid; i < 128 * 4096; i += gthreads) {
        const int bh = i >> 12, pr = i & 4095, h = bh & 3;
        const float g64 = exp2f(64.0f * log2f(1.0f - exp2f(-5.0f - (float)h)));
        const f32x2v S = *(const f32x2v*)(state_l + (size_t)bh * 8192 + 2 * pr);
        const size_t u = 1024 + bh;
        const f32x2v kv = *(const f32x2v*)(KV + u * 8192 + 2 * pr);
        *(unsigned*)(SC + u * 8192 + 2 * pr) = cvtpk(S[0], S[1]);
        *(f32x2v*)(ss_l + (size_t)bh * 8192 + 2 * pr) = (S + kv) * g64;
    }
}

#define BAR_LDS() asm volatile("s_waitcnt lgkmcnt(0)\n\ts_barrier" ::: "memory")
template <int NJT, bool ONLINE>
__device__ __forceinline__ void attn_tile(LAS unsigned char* kimg, LAS unsigned char* vimg, const bf16x8 (&qf)[4], const unsigned (&kaddr)[4], const unsigned (&vaddr)[4][2], f32x16 (&o)[4], float& l_acc, float& m_run, float negm0) {
    f32x16 p[NJT];
#pragma unroll
    for (int jt = 0; jt < NJT; ++jt) {
        f32x16 c;
#pragma unroll
        for (int r = 0; r < 16; ++r) c[r] = ONLINE ? 0.f : negm0;
#pragma unroll
        for (int s = 0; s < 4; ++s) {
            const bf16x8 kf = *(const LAS bf16x8*)(kimg + kaddr[s] + 8192 * jt);
            c = MFMA32(kf, qf[s], c);
        }
        p[jt] = c;
    }
    if (ONLINE) {
        float mx = -1e30f;
#pragma unroll
        for (int jt = 0; jt < NJT; ++jt)
#pragma unroll
            for (int r = 0; r < 16; ++r) mx = fmaxf(mx, p[jt][r]);
        mx = fmaxf(mx, __shfl_xor(mx, 32));
        const float mn = fmaxf(m_run, mx);
        const float al = __builtin_amdgcn_exp2f(m_run - mn);
        m_run = mn; l_acc *= al;
#pragma unroll
        for (int et = 0; et < 4; ++et)
#pragma unroll
            for (int r = 0; r < 16; ++r) o[et][r] *= al;
#pragma unroll
        for (int jt = 0; jt < NJT; ++jt)
#pragma unroll
            for (int r = 0; r < 16; ++r) p[jt][r] -= mn;
    }
    float ls = 0.f;
#pragma unroll
    for (int jt = 0; jt < NJT; ++jt)
#pragma unroll
        for (int r = 0; r < 16; ++r) { p[jt][r] = __builtin_amdgcn_exp2f(p[jt][r]); ls += p[jt][r]; }
    l_acc += ls;
#pragma unroll
    for (int jt = 0; jt < NJT; ++jt)
#pragma unroll
        for (int s2 = 0; s2 < 2; ++s2) {
            const bf16x8 xb = pack_step(p[jt], s2);
#pragma unroll
            for (int et = 0; et < 4; ++et) {
                const bf16x8 va = cat8(ds_tr(vimg, vaddr[et][0] + 256 * (32 * jt + 16 * s2)), ds_tr(vimg, vaddr[et][1] + 256 * (32 * jt + 16 * s2)));
                o[et] = MFMA32(va, xb, o[et]);
            }
        }
}
__device__ __forceinline__ void diff_finish(const f32x16 (&O)[4], size_t row, int h, const float* gsub, float lscale, bf16_t* MIX, int lane) {
    const int hi = lane >> 5;
    float ss = 0.f;
#pragma unroll
    for (int et = 0; et < 4; ++et)
#pragma unroll
        for (int r = 0; r < 16; ++r) ss += O[et][r] * O[et][r];
    ss += __shfl_xor(ss, 32);
    const float rs = lscale / sqrtf(ss * (1.0f / 128.0f) + EPS);
#pragma unroll
    for (int et = 0; et < 4; ++et)
#pragma unroll
        for (int rg = 0; rg < 4; ++rg) {
            const int e = 32 * et + 8 * rg + 4 * hi;
            const f32x4 g = *(const f32x4*)(gsub + e);
            const unsigned long long w = (unsigned long long)cvtpk(O[et][4 * rg] * rs * g[0], O[et][4 * rg + 1] * rs * g[1]) | ((unsigned long long)cvtpk(O[et][4 * rg + 2] * rs * g[2], O[et][4 * rg + 3] * rs * g[3]) << 32);
            *(unsigned long long*)(MIX + row * D + 512 + h * 128 + e) = w;
        }
}
__device__ __forceinline__ void attn_prompt_unit(int b, int h, int qb, const bf16_t* DQ, const bf16_t* DK, const bf16_t* DV, bf16_t* MIX, const float* gsub, float lam, float lscale, float negm0,
                                                 LAS unsigned char* lds, int tid, int wid, int lane) {
    const int sub = wid >> 2, iw = wid & 3, hi = lane >> 5, l32 = lane & 31;
    const int rowb = b * 2048, q0 = qb * 128 + 32 * iw;
    const int my_tiles = (q0 >> 6) + 1, NT = 2 * qb + 2;
    bf16x8 qf[4];
#pragma unroll
    for (int s = 0; s < 4; ++s) qf[s] = *(const bf16x8*)(DQ + (size_t)(rowb + q0 + l32) * 512 + h * 128 + sub * 64 + 16 * s + 8 * hi);
    f32x16 o[4];
#pragma unroll
    for (int et = 0; et < 4; ++et) o[et] = (f32x16){};
    float l_acc = 0.f, m_run = 0.f;
    unsigned kaddr[4], vaddr[4][2];
#pragma unroll
    for (int s = 0; s < 4; ++s) kaddr[s] = off_b(l32, sub * 8 + 2 * s + hi);
#pragma unroll
    for (int et = 0; et < 4; ++et) { vaddr[et][0] = tr_addr(lane, 4 * hi, et); vaddr[et][1] = tr_addr(lane, 8 + 4 * hi, et); }
    u32x4 kr[2], vr[2];
    const int srow[2] = {tid >> 4, (tid + 512) >> 4}, sch = tid & 15;
#define LOAD_TILE(t) do { _Pragma("unroll") for (int k_ = 0; k_ < 2; ++k_) { const size_t ro_ = (size_t)(rowb + 64 * (t) + srow[k_]) * 512 + h * 128 + sch * 8; \
        kr[k_] = *(const u32x4*)(DK + ro_); vr[k_] = *(const u32x4*)(DV + ro_); } } while (0)
#define WRITE_TILE(bf) do { _Pragma("unroll") for (int k_ = 0; k_ < 2; ++k_) { *(LAS u32x4*)(lds + (bf) * 32768 + off_b(srow[k_], sch)) = kr[k_]; *(LAS u32x4*)(lds + (bf) * 32768 + 16384 + off_b(srow[k_], sch)) = vr[k_]; } } while (0)
    LOAD_TILE(0); WRITE_TILE(0); BAR_LDS();
    for (int t = 0; t < NT; ++t) {
        const int bf = t & 1;
        if (t + 1 < NT) LOAD_TILE(t + 1);
        if (t < my_tiles) attn_tile<2, false>(lds + bf * 32768, lds + bf * 32768 + 16384, qf, kaddr, vaddr, o, l_acc, m_run, negm0);
        if (t + 1 < NT) WRITE_TILE(bf ^ 1);
        BAR_LDS();
    }
#undef LOAD_TILE
#undef WRITE_TILE
    l_acc += __shfl_xor(l_acc, 32);
    const float il = 1.0f / l_acc;
    LAS float* X = (LAS float*)(lds + 65536) + iw * 4096;
    if (sub == 1) {
        const float f = il * lam;
#pragma unroll
        for (int et = 0; et < 4; ++et)
#pragma unroll
            for (int r = 0; r < 16; ++r) X[(et * 16 + r) * 64 + lane] = o[et][r] * f;
    }
    BAR_LDS();
    if (sub == 0) {
#pragma unroll
        for (int et = 0; et < 4; ++et)
#pragma unroll
            for (int r = 0; r < 16; ++r) o[et][r] = o[et][r] * il - X[(et * 16 + r) * 64 + lane];
        diff_finish(o, (size_t)(rowb + q0 + l32), h, gsub, lscale, MIX, lane);
    }
    BAR_LDS();
}
__device__ __forceinline__ void attn_sample_unit(int unit, const float* ck_l, const float* cv_l, const bf16_t* DQ, const bf16_t* DK, const bf16_t* DV, float* PART,
                                                 LAS unsigned char* lds, int tid, int wid, int lane) {
    const int bh = unit >> 1, split = unit & 1, bs = bh >> 2, h = bh & 3;
    const int sub = wid >> 2, it = (wid >> 1) & 1, jh = wid & 1, hi = lane >> 5, l32 = lane & 31;
    const int rowq = MP + bs * 64;
    bf16x8 qf[4];
#pragma unroll
    for (int s = 0; s < 4; ++s) qf[s] = *(const bf16x8*)(DQ + (size_t)(rowq + 32 * it + l32) * 512 + h * 128 + sub * 64 + 16 * s + 8 * hi);
    f32x16 o[4];
#pragma unroll
    for (int et = 0; et < 4; ++et) o[et] = (f32x16){};
    float l_acc = 0.f, m_run = -1e30f;
    unsigned kaddr[4], vaddr[4][2];
#pragma unroll
    for (int s = 0; s < 4; ++s) kaddr[s] = off_b(l32, sub * 8 + 2 * s + hi);
#pragma unroll
    for (int et = 0; et < 4; ++et) { vaddr[et][0] = tr_addr(lane, 4 * hi, et); vaddr[et][1] = tr_addr(lane, 8 + 4 * hi, et); }
    const unsigned jo = 8192u * (unsigned)jh;
    const char* kb = (const char*)(ck_l + ((size_t)bs * 4096 + 2048 * split) * 512 + h * 128);
    const char* vb = (const char*)(cv_l + ((size_t)bs * 4096 + 2048 * split) * 512 + h * 128);
    const unsigned voff = (unsigned)(((tid >> 5) * 512 + (tid & 31) * 4) * 4);
    const unsigned wof = off_b((unsigned)(tid >> 5), (unsigned)((tid & 31) >> 1)) + 8u * (unsigned)(tid & 1);
    f32x4 kr[4], vr[4];
#define LOAD_TILE(tt_) do { const char* kt_ = kb + (size_t)(tt_) * (64 * 2048); const char* vt_ = vb + (size_t)(tt_) * (64 * 2048); \
        _Pragma("unroll") for (int k_ = 0; k_ < 4; ++k_) { kr[k_] = __builtin_nontemporal_load((const f32x4*)(kt_ + k_ * 32768 + voff)); vr[k_] = __builtin_nontemporal_load((const f32x4*)(vt_ + k_ * 32768 + voff)); } } while (0)
#define WRITE_TILE(bf) do { _Pragma("unroll") for (int k_ = 0; k_ < 4; ++k_) { \
            *(LAS unsigned long long*)(lds + (bf) * 32768 + k_ * 4096 + wof) = (unsigned long long)cvtpk(kr[k_][0], kr[k_][1]) | ((unsigned long long)cvtpk(kr[k_][2], kr[k_][3]) << 32); \
            *(LAS unsigned long long*)(lds + (bf) * 32768 + 16384 + k_ * 4096 + wof) = (unsigned long long)cvtpk(vr[k_][0], vr[k_][1]) | ((unsigned long long)cvtpk(vr[k_][2], vr[k_][3]) << 32); } } while (0)
    LOAD_TILE(0); WRITE_TILE(0); BAR_LDS();
#pragma unroll 1
    for (int tt = 0; tt < 32; ++tt) {
        const int bf = tt & 1;
        if (tt + 1 < 32) LOAD_TILE(tt + 1);
        attn_tile<1, true>(lds + bf * 32768 + jo, lds + bf * 32768 + 16384 + jo, qf, kaddr, vaddr, o, l_acc, m_run, 0.f);
        if (tt + 1 < 32) WRITE_TILE(bf ^ 1);
        BAR_LDS();
    }
#undef LOAD_TILE
#undef WRITE_TILE
    if (split == 1) {
#pragma unroll
        for (int k_ = 0; k_ < 2; ++k_) { const size_t ro_ = (size_t)(rowq + (tid >> 4) + 32 * k_) * 512 + h * 128 + (tid & 15) * 8; const unsigned of_ = off_b((unsigned)((tid >> 4) + 32 * k_), (unsigned)(tid & 15));
            *(LAS u32x4*)(lds + of_) = *(const u32x4*)(DK + ro_); *(LAS u32x4*)(lds + 16384 + of_) = *(const u32x4*)(DV + ro_); }
        BAR_LDS();
        attn_tile<1, true>(lds + jo, lds + 16384 + jo, qf, kaddr, vaddr, o, l_acc, m_run, 0.f);
        BAR_LDS();
    }
    l_acc += __shfl_xor(l_acc, 32);
    float* P = PART + ((size_t)unit * 8 + wid) * (66 * 64) + lane;
#pragma unroll
    for (int et = 0; et < 4; ++et)
#pragma unroll
        for (int r = 0; r < 16; ++r) P[(et * 16 + r) * 64] = o[et][r];
    P[64 * 64] = m_run; P[65 * 64] = l_acc;
}
__device__ __forceinline__ void attn_sample_combine(int item, const float* PART, bf16_t* MIX, const float* gsub, float lam, float lscale, LAS float* xs, int lane) {
    const int bh = item >> 1, it = item & 1, bs = bh >> 2, h = bh & 3, l32 = lane & 31, hi = lane >> 5;
    const float* P0 = PART + ((size_t)(bh * 2) * 8 + it * 2) * (66 * 64) + lane;
    float w[8];
#pragma unroll
    for (int sub = 0; sub < 2; ++sub) {
        float m[4], l[4];
#pragma unroll
        for (int k = 0; k < 4; ++k) { const float* q = P0 + (size_t)((k >> 1) * 8 + sub * 4 + (k & 1)) * (66 * 64); m[k] = q[64 * 64]; l[k] = q[65 * 64]; }
        const float mm = fmaxf(fmaxf(m[0], m[1]), fmaxf(m[2], m[3]));
        float L = 0.f;
#pragma unroll
        for (int k = 0; k < 4; ++k) { w[sub * 4 + k] = __builtin_amdgcn_exp2f(m[k] - mm); L += w[sub * 4 + k] * l[k]; }
        const float iL = (sub == 0 ? 1.0f : -lam) / L;
#pragma unroll
        for (int k = 0; k < 4; ++k) w[sub * 4 + k] *= iL;
    }
    float ss = 0.f;
#pragma unroll 1
    for (int q = 0; q < 64; q += 4) {
#pragma unroll
        for (int k4 = 0; k4 < 4; ++k4) {
            const float* pq = P0 + (size_t)(q + k4) * 64; float v = 0.f;
#pragma unroll
            for (int j = 0; j < 8; ++j) v += w[j] * pq[(size_t)((((j & 3) >> 1) * 8) + (j >> 2) * 4 + (j & 1)) * (66 * 64)];
            ss += v * v; xs[(q + k4) * 64 + lane] = v;
        }
    }
    ss += __shfl_xor(ss, 32);
    const float rs = lscale / sqrtf(ss * (1.0f / 128.0f) + EPS);
    LDS_WAIT(); asm volatile("" ::: "memory");
    const size_t row = (size_t)(MP + bs * 64 + 32 * it + l32);
#pragma unroll 1
    for (int q = 0; q < 16; ++q) {
        const int e = 32 * (q >> 2) + 8 * (q & 3) + 4 * hi;
        const f32x4 g = *(const f32x4*)(gsub + e);
        const float v0 = xs[(4 * q) * 64 + lane], v1 = xs[(4 * q + 1) * 64 + lane], v2 = xs[(4 * q + 2) * 64 + lane], v3 = xs[(4 * q + 3) * 64 + lane];
        const unsigned long long wv = (unsigned long long)cvtpk(v0 * rs * g[0], v1 * rs * g[1]) | ((unsigned long long)cvtpk(v2 * rs * g[2], v3 * rs * g[3]) << 32);
        *(unsigned long long*)(MIX + row * D + 512 + h * 128 + e) = wv;
    }
    LDS_WAIT(); asm volatile("" ::: "memory");
}

struct Args { const float* in[17]; float* out; unsigned char* ws; int ph_lo, ph_hi; };
constexpr int NPL = 12;
constexpr int NPHASES = 1 + 2 * NPL;

__global__ void __launch_bounds__(NTHREADS, 2) fwd_kernel(Args a) {
    extern __shared__ __attribute__((aligned(16))) unsigned char lds_raw[];
    LAS unsigned char* lds = (LAS unsigned char*)lds_raw;
    {
        volatile LAS unsigned* Z = (volatile LAS unsigned*)(lds + RING_BYTES);
        for (int u = threadIdx.x; u < (LDS_BYTES - RING_BYTES) / 4; u += NTHREADS) Z[u] = 0u;
    }
    __syncthreads();
    XcdBarrier bar = xcd_barrier_post((unsigned*)((gu32*)(a.ws + WS_CTL) + CW_BAR), (volatile LAS unsigned*)(lds + MISC_OFF) + 8);
    const int lo = a.ph_lo, hi = a.ph_hi;
#ifndef PHMASK
#define PHMASK 0xFFFF
#endif
#define EN(b) ((PHMASK >> (b)) & 1)
#define IN_PH(k) (lo <= (k) && (k) < hi)
#define SEAM(k) do { if ((k) + 1 < hi) xcd_barrier(bar); } while (0)
#define PH_BEGIN() int tid = threadIdx.x, l = l_; asm volatile("" : "+v"(tid)); asm volatile("" : "+s"(l)); \
    const int lane = tid & 63, wid = __builtin_amdgcn_readfirstlane(tid >> 6); const int G = gridDim.x, bx = blockIdx.x; \
    const int vcu = (G % 8 == 0) ? (bx % 8) * (G / 8) + bx / 8 : bx; \
    const int gw = vcu * NWAVES + wid, ngw = G * NWAVES, gtid = vcu * NTHREADS + tid, gthreads = G * NTHREADS; \
    unsigned char* ws = a.ws; float* out = a.out; float* X = out; (void)lane; (void)wid; (void)gw; (void)ngw; (void)gtid; (void)gthreads; (void)ws; (void)X; (void)vcu; \
    const float* mod_l = (const float*)(ws + WS_MOD) + (size_t)l * NSEQ * NMOD; (void)mod_l
#define WSP(T, off) ((T*)(ws + (off)))

    if (EN(0) && IN_PH(0)) {
        const int l_ = 0; PH_BEGIN();
        for (int item = bx; item < 288; item += G) adaln_item(item, a.in[5], a.in[6], a.in[7], a.in[8], WSP(float, WS_MOD), lds, tid, wid, lane);
        trig_fill(WSP(float, WS_TRIG), gtid, gthreads);
        LAS float* scr = (LAS float*)(lds + wid * 16384);
        const float *w_ff_up = a.in[10], *w_ff_down = a.in[11], *w_in = a.in[12], *w_out = a.in[13];
        bf16_t *Wup = WSP(bf16_t, WS_WUP), *Wdn = WSP(bf16_t, WS_WDN), *Win = WSP(bf16_t, WS_WIN), *Wout = WSP(bf16_t, WS_WOUT);
        constexpr int I_UP = 16 * 176, I_DN = 44 * 32, I_IN = 16 * 96, I_OUT = 16 * 32;
        constexpr int NITEMS = 4 * I_UP + 4 * I_DN + 2 * I_IN + 2 * I_OUT;
        for (int itm = gw; itm < NITEMS; itm += ngw) {
            int r = itm;
            if (r < 4 * I_UP) { const int mat = r / I_UP; r -= mat * I_UP; const int kb = r / 176, g = r % 176;
                const int pn = g >> 3, bj = (g >> 2) & 1, wc = g & 3;
                transpose_item(w_ff_up + (size_t)mat * D * NUP, D, NUP, Wup + (size_t)mat * NUP * D, 32 * g, (bj ? DFF : 0) + 128 * pn + 32 * wc, 64 * kb, scr, lane); continue; }
            r -= 4 * I_UP;
            if (r < 4 * I_DN) { const int mat = r / I_DN; r -= mat * I_DN; const int kb = r / 32, g = r % 32;
                transpose_item(w_ff_down + (size_t)mat * DFF * D, DFF, D, Wdn + (size_t)mat * D * DFF, 32 * g, 32 * g, 64 * kb, scr, lane); continue; }
            r -= 4 * I_DN;
            if (r < 2 * I_IN) { const int mat = r / I_IN; r -= mat * I_IN; const int kb = r / 96, g = r % 96;
                const int pn = g >> 3, bj = (g >> 2) & 1, wc = g & 3;
                const int src = (pn >= 6 && pn <= 9) ? 256 * pn + 64 * wc + 32 * bj : 32 * g;
                transpose_item(w_in + (size_t)mat * D * DIN, D, DIN, Win + (size_t)mat * DIN * D, 32 * g, src, 64 * kb, scr, lane); continue; }
            r -= 2 * I_IN;
            { const int mat = r / I_OUT; r -= mat * I_OUT; const int kb = r / 32, g = r % 32;
                transpose_item(w_out + (size_t)mat * D * D, D, D, Wout + (size_t)mat * D * D, 32 * g, 32 * g, 64 * kb, scr, lane); }
        }
        SEAM(0);
    }

    for (int l_ = 0; l_ < 2; ++l_) {
        const int pb = 1 + l_ * NPL;
        if (EN(1) && IN_PH(pb + 0)) { PH_BEGIN();
            const float* xin_p = l == 0 ? a.in[0] : X; const float* xin_s = l == 0 ? a.in[1] : X + (size_t)MP * D;
            norm_phase(xin_p, xin_s, a.in[9] + (size_t)(l * 3 + 0) * D, mod_l, 0, WSP(bf16_t, WS_H), gw, ngw, lane); SEAM(pb + 0); }
        if (EN(2) && IN_PH(pb + 1)) { PH_BEGIN();
            pg8::Gemm g{WSP(bf16_t, WS_H), WSP(bf16_t, WS_WUP) + (size_t)(l * 2 + 0) * NUP * D, M, NUP, D}; pg8::StaticOrder S; S.init(M, NUP, G, bx);
            EpiUp E{WSP(bf16_t, WS_ACT)};
            pg8::gemm_phase<EpiUp, pg8::StaticOrder, true, true>(lds, g, S, E);
            SEAM(pb + 1);
        }
        if (EN(3) && IN_PH(pb + 2)) { PH_BEGIN();
            const float* xin_p = l == 0 ? a.in[0] : X; const float* xin_s = l == 0 ? a.in[1] : X + (size_t)MP * D;
            pg8::Gemm g{WSP(bf16_t, WS_ACT), WSP(bf16_t, WS_WDN) + (size_t)(l * 2 + 0) * D * DFF, M, D, DFF}; pg8::StaticOrder S; S.init(M, D, G, bx);
            EpiRes E{xin_p, xin_s, X, mod_l + 2 * D, 0.5f};
            pg8::gemm_phase<EpiRes, pg8::StaticOrder, true, true>(lds, g, S, E);
            SEAM(pb + 2);
        }
        if (EN(1) && IN_PH(pb + 3)) { PH_BEGIN(); norm_phase(X, X + (size_t)MP * D, a.in[9] + (size_t)(l * 3 + 1) * D, mod_l, 1, WSP(bf16_t, WS_H), gw, ngw, lane); SEAM(pb + 3); }
        if (EN(4) && IN_PH(pb + 4)) { PH_BEGIN();
            pg8::Gemm g{WSP(bf16_t, WS_H), WSP(bf16_t, WS_WIN) + (size_t)l * DIN * D, M, DIN, D}; pg8::StaticOrder S; S.init(M, DIN, G, bx);
            EpiIn E{WSP(bf16_t, WS_RQ), WSP(bf16_t, WS_RK), WSP(bf16_t, WS_RV), WSP(bf16_t, WS_SG), WSP(bf16_t, WS_DQ), WSP(bf16_t, WS_DK), WSP(bf16_t, WS_DV),
                    out + O_KP + (size_t)l * MP * 512, out + O_KS + (size_t)l * MS * 512, out + O_VP + (size_t)l * MP * 512, out + O_VS + (size_t)l * MS * 512, WSP(float, WS_TRIG), a.in[14] + (size_t)l * 128};
            pg8::gemm_phase<EpiIn, pg8::StaticOrder, true, true>(lds, g, S, E);
            SEAM(pb + 4);
        }
#define LAMBDA_SETUP() float lam, negm0; const float lam_init = l == 0 ? 0.2f : 0.35550906759096926f; { \
            const float* wl = a.in[15] + (size_t)l * 256; const float* gq_ = a.in[14] + (size_t)l * 128; \
            const float s1 = wave_sum(wl[lane] * wl[64 + lane]), s2 = wave_sum(wl[128 + lane] * wl[192 + lane]); \
            lam = __expf(s1) - __expf(s2) + lam_init; \
            const float gq = wave_max(fabsf(gq_[lane])), gk = wave_max(fabsf(gq_[64 + lane])); \
            negm0 = -(C2 * 64.0f * gq * gk * 1.02f); } \
            const float lscale = 1.0f - lam_init; const float* gsub_l = a.in[16] + (size_t)l * 128; (void)negm0; (void)lscale; (void)gsub_l
        if (IN_PH(pb + 5)) {
            if (EN(5)) { PH_BEGIN();
                for (int unit = bx; unit < 256; unit += G)
                    attn_sample_unit(unit, a.in[2] + (size_t)l * 32 * 4096 * 512, a.in[3] + (size_t)l * 32 * 4096 * 512, WSP(bf16_t, WS_DQ), WSP(bf16_t, WS_DK), WSP(bf16_t, WS_DV), WSP(float, WS_PART), lds, tid, wid, lane);
            }
            __syncthreads();
            if (EN(6)) { PH_BEGIN(); LAMBDA_SETUP();
                for (int pr = vcu; pr < 256; pr += G) {
                    const int bh = pr >> 3, s = pr & 7;
                    attn_prompt_unit(bh >> 2, bh & 3, s, WSP(bf16_t, WS_DQ), WSP(bf16_t, WS_DK), WSP(bf16_t, WS_DV), WSP(bf16_t, WS_MIX), gsub_l, lam, lscale, negm0, lds, tid, wid, lane);
                    attn_prompt_unit(bh >> 2, bh & 3, 15 - s, WSP(bf16_t, WS_DQ), WSP(bf16_t, WS_DK), WSP(bf16_t, WS_DV), WSP(bf16_t, WS_MIX), gsub_l, lam, lscale, negm0, lds, tid, wid, lane);
                }
            }
            __syncthreads();
            if (EN(7)) { PH_BEGIN();
                for (int item = gw; item < 2304; item += ngw) ret_kv_item(item, WSP(bf16_t, WS_RK), WSP(bf16_t, WS_RV), WSP(float, WS_KV), lds + wid * 16384, lane);
            }
            SEAM(pb + 5);
        }
        if (IN_PH(pb + 6)) { PH_BEGIN(); LAMBDA_SETUP();
            if (EN(8)) scan_phase(WSP(float, WS_KV), WSP(bf16_t, WS_SC), a.in[4] + (size_t)l * 128 * 8192, out + O_SP + (size_t)l * 32 * 8192, out + O_SS + (size_t)l * 128 * 8192, gtid, gthreads);
            if (EN(10)) for (int item = gw; item < 256; item += ngw) attn_sample_combine(item, WSP(float, WS_PART), WSP(bf16_t, WS_MIX), gsub_l, lam, lscale, (LAS float*)(lds + wid * 16384), lane);
            SEAM(pb + 6);
        }
        if (EN(9) && IN_PH(pb + 7)) { PH_BEGIN();
            for (int item = gw; item < 2304; item += ngw) ret_out_item(item, WSP(bf16_t, WS_RQ), WSP(bf16_t, WS_RK), WSP(bf16_t, WS_RV), WSP(bf16_t, WS_SG), WSP(bf16_t, WS_SC), WSP(bf16_t, WS_MIX), lds + wid * 16384, lane);
            SEAM(pb + 7);
        }
        if (EN(3) && IN_PH(pb + 8)) { PH_BEGIN();
            pg8::Gemm g{WSP(bf16_t, WS_MIX), WSP(bf16_t, WS_WOUT) + (size_t)l * D * D, M, D, D}; pg8::StaticOrder S; S.init(M, D, G, bx);
            EpiRes E{X, X + (size_t)MP * D, X, mod_l + 5 * D, 1.0f};
            pg8::gemm_phase<EpiRes, pg8::StaticOrder, true, true>(lds, g, S, E);
            SEAM(pb + 8);
        }
        if (EN(1) && IN_PH(pb + 9)) { PH_BEGIN(); norm_phase(X, X + (size_t)MP * D, a.in[9] + (size_t)(l * 3 + 2) * D, mod_l, 2, WSP(bf16_t, WS_H), gw, ngw, lane); SEAM(pb + 9); }
        if (EN(2) && IN_PH(pb + 10)) { PH_BEGIN();
            pg8::Gemm g{WSP(bf16_t, WS_H), WSP(bf16_t, WS_WUP) + (size_t)(l * 2 + 1) * NUP * D, M, NUP, D}; pg8::StaticOrder S; S.init(M, NUP, G, bx);
            EpiUp E{WSP(bf16_t, WS_ACT)};
            pg8::gemm_phase<EpiUp, pg8::StaticOrder, true, true>(lds, g, S, E);
            SEAM(pb + 10);
        }
        if (EN(3) && IN_PH(pb + 11)) { PH_BEGIN();
            pg8::Gemm g{WSP(bf16_t, WS_ACT), WSP(bf16_t, WS_WDN) + (size_t)(l * 2 + 1) * D * DFF, M, D, DFF}; pg8::StaticOrder S; S.init(M, D, G, bx);
            EpiRes E{X, X + (size_t)MP * D, X, mod_l + 8 * D, 0.5f};
            pg8::gemm_phase<EpiRes, pg8::StaticOrder, true, true>(lds, g, S, E);
            SEAM(pb + 11);
        }
    }
#undef IN_PH
#undef SEAM
}

#ifndef MK_N_LAUNCHES
#define MK_N_LAUNCHES 1
#endif
extern "C" void kernel_launch(void* const* d_in, const int* in_sizes, int n_in, void* d_out, int out_size, void* d_ws, size_t ws_size, hipStream_t stream) {
    static int grid = 0;
    if (grid == 0) {
        if (n_in != 17 || ws_size < WS_END) { fprintf(stderr, "kernel_launch: unexpected n_in %d / ws %zu\n", n_in, ws_size); grid = -1; return; }
        int dev = 0, cus = 0, per_cu = 0;
        if (hipGetDevice(&dev) != hipSuccess || hipDeviceGetAttribute(&cus, hipDeviceAttributeMultiprocessorCount, dev) != hipSuccess) { grid = -1; return; }
        if (hipFuncSetAttribute((const void*)fwd_kernel, hipFuncAttributeMaxDynamicSharedMemorySize, LDS_BYTES) != hipSuccess) { fprintf(stderr, "kernel_launch: hipFuncSetAttribute failed\n"); grid = -1; return; }
        if (hipOccupancyMaxActiveBlocksPerMultiprocessor(&per_cu, (const void*)fwd_kernel, NTHREADS, LDS_BYTES) != hipSuccess || per_cu < 1)
            fprintf(stderr, "kernel_launch: occupancy query reports %d blocks per CU\n", per_cu);
        (void)hipGetLastError();
        grid = cus < 256 ? cus : 256;
    }
    if (grid < 0) return;
    if (hipMemsetAsync((char*)d_ws + WS_CTL, 0, CTL_ZERO_BYTES, stream) != hipSuccess) return;
    Args a{};
    for (int i = 0; i < 17; ++i) a.in[i] = (const float*)d_in[i];
    a.out = (float*)d_out; a.ws = (unsigned char*)d_ws;
    if (MK_N_LAUNCHES == 1) {
        a.ph_lo = 0; a.ph_hi = NPHASES;
        hipLaunchKernelGGL(fwd_kernel, dim3(grid), dim3(NTHREADS), LDS_BYTES, stream, a);
    } else {
        for (int p = 0; p < NPHASES; ++p) { a.ph_lo = p; a.ph_hi = p + 1; hipLaunchKernelGGL(fwd_kernel, dim3(grid), dim3(NTHREADS), LDS_BYTES, stream, a); }
    }
}
```

```cpp
#include <hip/hip_runtime.h>
#include <cstdio>
#include <cstdint>
namespace pg8 {
#define PG8_LAS __attribute__((address_space(3)))
typedef unsigned short bf16_t;
typedef short bf16x8 __attribute__((ext_vector_type(8)));
typedef float f32x4 __attribute__((ext_vector_type(4)));
typedef unsigned u32x4 __attribute__((ext_vector_type(4)));
constexpr int BM = 256, BK = 64, HALF = 128, HTB = HALF * BK * 2  , STAGE_BYTES = 8 * HTB, NXCD = 8, WGM = 4;

__host__ __device__ __forceinline__ int lds_byte(int r, int c) { const int st = (r >> 4) * 2 + (c >> 5), rr = r & 15, cc = c & 31, ob = rr * 64 + cc * 2; return st * 1024 + (ob ^ (((ob >> 9) & 1) << 5)); }
__host__ __device__ __forceinline__ void stage_rc(int b, int& R, int& C) { const int st = b / 1024, sb = b % 1024, swz = sb ^ (((sb >> 9) & 1) << 5); R = (st >> 1) * 16 + swz / 64; C = (st & 1) * 32 + (swz % 64) / 2; }
__host__ __device__ __forceinline__ int perm32(int rho) { const int n = rho >> 4, i = rho & 15; return 8 * (i >> 2) + 4 * n + (i & 3); }

struct Unit { int pm, pn, kt0, nkt, aux, half; };
struct Gemm { const bf16_t* A; const bf16_t* Bt; int M, N, K; };

struct StaticOrder {
    int nM, nN, nwg, G, c;
    __host__ __device__ __forceinline__ void init(int M, int N, int G_, int c_) { nM = M / BM; nN = N / BM; nwg = nM * nN; G = G_; c = c_; }
    __host__ __device__ __forceinline__ bool next(int i, Unit& u) const { return at((long)i * G + c, u); }
    __host__ __device__ __forceinline__ bool at(long L, Unit& u) const {
        if (L >= nwg) return false;
        int wgid = (int)L; { const int q = nwg / NXCD, r = nwg % NXCD, xcd = wgid % NXCD, off = wgid / NXCD; wgid = (xcd < r ? xcd * (q + 1) : r * (q + 1) + (xcd - r) * q) + off; }
        const int nig = WGM * nN, gid = wgid / nig, fm = gid * WGM, gsz = (nM - fm) < WGM ? (nM - fm) : WGM;
        u.pm = fm + ((wgid % nig) % gsz); u.pn = (wgid % nig) / gsz; u.kt0 = 0; u.nkt = 0; u.aux = 0; u.half = 0; return true;
    }
    __device__ __forceinline__ void a_ready(const Unit&) const {}
    __device__ __forceinline__ void done(const Unit&) const {}
};

__device__ __forceinline__ unsigned cvt_pk_bf16(float lo, float hi) { unsigned r; asm volatile("v_cvt_pk_bf16_f32 %0, %1, %2" : "=v"(r) : "v"(lo), "v"(hi)); return r; }
typedef float f32x2 __attribute__((ext_vector_type(2)));
template <class Epi, class Sched, bool ALIGN_EPI = false, bool SP2 = false>
__device__ __forceinline__ void gemm_phase(PG8_LAS unsigned char* lds, const Gemm g, const Sched& S, const Epi& E, int tid) {
    asm volatile("" : "+v"(tid));
    const int wid = __builtin_amdgcn_readfirstlane(tid >> 6), lane = tid & 63, wr = wid >> 2, wc = wid & 3, fr = lane & 15, fq = lane >> 4;
    const int K = g.K, ntK = K / BK;
    unsigned voffA[2], voffB[2];
#pragma unroll
    for (int i = 0; i < 2; ++i) { int R, C; stage_rc(tid * 16 + i * 8192, R, C); const int Rb = Epi::PERM ? ((R & ~31) + perm32(R & 31)) : R;
        voffA[i] = (unsigned)(R * K + C) * 2u; voffB[i] = (unsigned)(Rb * K + C) * 2u; }
    const size_t kstep = (size_t)(BK * 2);
    const size_t hstep = (size_t)HALF * K * 2;
    const size_t tstep = 2 * hstep;
    const unsigned ldsw = (unsigned)wid * 1024u;
    const int aoff = lds_byte(wr * 64 + fr, fq * 8), boff = lds_byte(wc * 32 + fr, fq * 8);
#define PG8_SA(b, h) (((b) * 2 + (h)) * HTB)
#define PG8_SB(b, h) ((4 + (b) * 2 + (h)) * HTB)
#define PG8_STAGE(bufoff, gbase, voff) do { _Pragma("unroll") for (int _i = 0; _i < 2; ++_i) \
        __builtin_amdgcn_global_load_lds((const unsigned*)((const char*)(gbase) + (voff)[_i]), (PG8_LAS unsigned*)(lds + (bufoff) + ldsw + _i * 8192), 16, 0, 0); } while (0)
#define PG8_LDA(dst, b, h) do { _Pragma("unroll") for (int m = 0; m < 4; ++m) _Pragma("unroll") for (int k = 0; k < 2; ++k) dst[m][k] = *(const PG8_LAS bf16x8*)(lds + PG8_SA(b, h) + aoff + m * 2048 + k * 1024); } while (0)
#define PG8_LDB(dst, b, h) do { _Pragma("unroll") for (int n = 0; n < 2; ++n) _Pragma("unroll") for (int k = 0; k < 2; ++k) dst[n][k] = *(const PG8_LAS bf16x8*)(lds + PG8_SB(b, h) + boff + n * 2048 + k * 1024); } while (0)
#define PG8_MMA(ai, bj, At, Bt) do { __builtin_amdgcn_s_setprio(1); _Pragma("unroll") for (int m = 0; m < 4; ++m) _Pragma("unroll") for (int n = 0; n < 2; ++n) _Pragma("unroll") for (int k = 0; k < 2; ++k) \
        acc[ai][bj][m][n] = __builtin_amdgcn_mfma_f32_16x16x32_bf16(Bt[n][k], At[m][k], acc[ai][bj][m][n], 0, 0, 0); __builtin_amdgcn_s_setprio(0); } while (0)
#define PG8_WAIT_V(n) asm volatile("s_waitcnt vmcnt(" #n ")" ::: "memory")
#define PG8_WAIT_L(n) asm volatile("s_waitcnt lgkmcnt(" #n ")" ::: "memory")
#define PG8_BAR __builtin_amdgcn_s_barrier()
#define PG8_SCHED __builtin_amdgcn_sched_barrier(0)
    Unit cur, nxt; int ui = 0;
    if (!S.next(0, cur)) return;
    f32x4 acc[2][2][4][2];
#pragma unroll
    for (int a = 0; a < 2; ++a)
#pragma unroll
        for (int b = 0; b < 2; ++b)
#pragma unroll
            for (int m = 0; m < 4; ++m)
#pragma unroll
                for (int n = 0; n < 2; ++n) acc[a][b][m][n] = (f32x4){0.f, 0.f, 0.f, 0.f};
    bf16x8 At[4][2], B0[2][2], B1[2][2];
    const char* cA = (const char*)g.A + (size_t)cur.pm * tstep + (size_t)cur.kt0 * kstep + (cur.half == 2 ? hstep : 0); const char* cB = (const char*)g.Bt + (size_t)cur.pn * tstep + (size_t)cur.kt0 * kstep;
    S.a_ready(cur);
    if constexpr (SP2) {
        PG8_STAGE(PG8_SB(0, 0), cB, voffB); PG8_STAGE(PG8_SB(0, 1), cB + hstep, voffB); PG8_STAGE(PG8_SA(0, 0), cA, voffA); PG8_STAGE(PG8_SA(0, 1), cA + hstep, voffA);
        if (wr == 1) PG8_BAR;
        PG8_WAIT_V(2); PG8_BAR;
        PG8_STAGE(PG8_SB(1, 0), cB + kstep, voffB); PG8_STAGE(PG8_SA(1, 0), cA + kstep, voffA); PG8_STAGE(PG8_SB(1, 1), cB + hstep + kstep, voffB);
        PG8_WAIT_V(6); PG8_BAR;
    } else {
        PG8_STAGE(PG8_SB(0, 0), cB, voffB); PG8_STAGE(PG8_SA(0, 0), cA, voffA); PG8_STAGE(PG8_SB(0, 1), cB + hstep, voffB); PG8_STAGE(PG8_SA(0, 1), cA + hstep, voffA);
        if (wr == 1) PG8_BAR;
        PG8_WAIT_V(4); PG8_BAR;
        PG8_STAGE(PG8_SB(1, 0), cB + kstep, voffB); PG8_STAGE(PG8_SA(1, 0), cA + kstep, voffA); PG8_STAGE(PG8_SB(1, 1), cB + hstep + kstep, voffB);
        PG8_WAIT_V(6); PG8_BAR;
    }
    for (;;) {
        const bool has_next = S.next(ui + 1, nxt);
        const char* nA = has_next ? (const char*)g.A + (size_t)nxt.pm * tstep + (size_t)nxt.kt0 * kstep + (nxt.half == 2 ? hstep : 0) : cA; const char* nB = has_next ? (const char*)g.Bt + (size_t)nxt.pn * tstep + (size_t)nxt.kt0 * kstep : cB;
        const int nt = cur.nkt ? cur.nkt : ntK; const bool full = cur.half == 0;
        for (int t = 0; t < nt; t += 2) {
            const bool last = (t == nt - 2);
            const char* a1 = cA + (size_t)(t + 1) * kstep;
            const char* a2 = last ? nA : cA + (size_t)(t + 2) * kstep; const char* b2 = last ? nB : cB + (size_t)(t + 2) * kstep;
            const char* a3 = a2 + kstep; const char* b3 = b2 + kstep;
            if (last && has_next) S.a_ready(nxt);
            if constexpr (SP2) {
            PG8_LDB(B0, 0, 0); PG8_LDB(B1, 0, 1); PG8_SCHED; PG8_LDA(At, 0, 0); PG8_STAGE(PG8_SA(1, 1), a1 + hstep, voffA);
            PG8_WAIT_V(8); PG8_WAIT_L(0); PG8_BAR; PG8_MMA(0, 0, At, B0); PG8_MMA(0, 1, At, B1); PG8_BAR; PG8_SCHED;
            if (full) PG8_LDA(At, 0, 1); PG8_STAGE(PG8_SB(0, 0), b2, voffB); PG8_STAGE(PG8_SB(0, 1), b2 + hstep, voffB); PG8_STAGE(PG8_SA(0, 0), a2, voffA);
            PG8_WAIT_V(8); PG8_WAIT_L(0); PG8_BAR; if (full) { PG8_MMA(1, 0, At, B0); PG8_MMA(1, 1, At, B1); } PG8_BAR; PG8_SCHED;
            PG8_LDB(B0, 1, 0); PG8_LDB(B1, 1, 1); PG8_SCHED; PG8_LDA(At, 1, 0); PG8_STAGE(PG8_SA(0, 1), a2 + hstep, voffA);
            PG8_WAIT_V(8); PG8_WAIT_L(0); PG8_BAR; PG8_MMA(0, 0, At, B0); PG8_MMA(0, 1, At, B1); PG8_BAR; PG8_SCHED;
            if (full) PG8_LDA(At, 1, 1); PG8_STAGE(PG8_SB(1, 0), b3, voffB); PG8_STAGE(PG8_SB(1, 1), b3 + hstep, voffB); PG8_STAGE(PG8_SA(1, 0), a3, voffA);
            PG8_WAIT_V(8); PG8_WAIT_L(0); PG8_BAR; if (full) { PG8_MMA(1, 0, At, B0); PG8_MMA(1, 1, At, B1); } PG8_BAR; PG8_SCHED;
            } else {
            PG8_LDB(B0, 0, 0); PG8_SCHED; PG8_LDA(At, 0, 0); PG8_STAGE(PG8_SA(1, 1), a1 + hstep, voffA);
            PG8_WAIT_L(8); PG8_BAR; PG8_WAIT_L(0); PG8_MMA(0, 0, At, B0); PG8_BAR; PG8_SCHED;
            PG8_LDB(B1, 0, 1); PG8_STAGE(PG8_SB(0, 0), b2, voffB);
            PG8_BAR; PG8_WAIT_L(0); PG8_MMA(0, 1, At, B1); PG8_BAR;
            PG8_LDA(At, 0, 1); PG8_STAGE(PG8_SA(0, 0), a2, voffA);
            PG8_BAR; PG8_WAIT_L(0); PG8_MMA(1, 0, At, B0); PG8_BAR; PG8_SCHED;
            PG8_STAGE(PG8_SB(0, 1), b2 + hstep, voffB);
            PG8_WAIT_V(6); PG8_BAR; PG8_MMA(1, 1, At, B1); PG8_BAR;
            PG8_LDB(B0, 1, 0); PG8_SCHED; PG8_LDA(At, 1, 0); PG8_STAGE(PG8_SA(0, 1), a2 + hstep, voffA);
            PG8_WAIT_L(8); PG8_BAR; PG8_WAIT_L(0); PG8_MMA(0, 0, At, B0); PG8_BAR; PG8_SCHED;
            PG8_LDB(B1, 1, 1); PG8_STAGE(PG8_SB(1, 0), b3, voffB);
            PG8_BAR; PG8_WAIT_L(0); PG8_MMA(0, 1, At, B1); PG8_BAR;
            PG8_LDA(At, 1, 1); PG8_STAGE(PG8_SA(1, 0), a3, voffA);
            PG8_BAR; PG8_WAIT_L(0); PG8_MMA(1, 0, At, B0); PG8_BAR; PG8_SCHED;
            PG8_STAGE(PG8_SB(1, 1), b3 + hstep, voffB);
            PG8_WAIT_V(6); PG8_BAR; PG8_MMA(1, 1, At, B1); PG8_BAR;
            }
        }
        if constexpr (ALIGN_EPI) { if (wr == 0) PG8_BAR; }
        if constexpr (!Epi::AFTER_DRAIN) { E(acc, cur, wr, wc, fr, fq); S.done(cur); }
        if (!has_next) break;
#pragma unroll
        for (int a = 0; a < 2; ++a)
#pragma unroll
            for (int b = 0; b < 2; ++b)
#pragma unroll
                for (int m = 0; m < 4; ++m)
#pragma unroll
                    for (int n = 0; n < 2; ++n) acc[a][b][m][n] = (f32x4){0.f, 0.f, 0.f, 0.f};
        cur = nxt; cA = nA; cB = nB; ++ui;
        if constexpr (ALIGN_EPI) { if (wr == 1) PG8_BAR; }
    }
    PG8_WAIT_V(0);
    if constexpr (!ALIGN_EPI) { if (wr == 0) PG8_BAR; }
    PG8_BAR;
    if constexpr (Epi::AFTER_DRAIN) { E.fused(acc, cur, wr, wc, fr, fq, lds, wid, lane); S.done(cur); }
#undef PG8_SA
#undef PG8_SB
#undef PG8_STAGE
#undef PG8_LDA
#undef PG8_LDB
#undef PG8_MMA
#undef PG8_WAIT_V
#undef PG8_WAIT_L
#undef PG8_BAR
#undef PG8_SCHED
}
}
#define GAS __attribute__((address_space(1)))
#define LAS __attribute__((address_space(3)))
typedef unsigned short bf16;
typedef unsigned v4u __attribute__((ext_vector_type(4)));
typedef float f32x4 __attribute__((ext_vector_type(4)));
typedef short bf16x8 __attribute__((ext_vector_type(8)));
typedef GAS unsigned gu32;
typedef GAS unsigned long long gu64;
#define RLX_AGENT __ATOMIC_RELAXED, __HIP_MEMORY_SCOPE_AGENT
#define LDS_WAIT() asm volatile("s_waitcnt lgkmcnt(0)" ::: "memory")
#define VM_WAIT() asm volatile("s_waitcnt vmcnt(0)" ::: "memory")
__device__ __forceinline__ unsigned long long rt() { return __builtin_amdgcn_s_memrealtime(); }
__device__ __forceinline__ unsigned f2bf(float f) { unsigned u = __builtin_bit_cast(unsigned, f); return (u + 0x7fffu + ((u >> 16) & 1u)) >> 16; }
__device__ __forceinline__ unsigned pk2(float lo, float hi) { return f2bf(lo) | (f2bf(hi) << 16); }

#define XB_TMO      128
#define XB_XCNT(j)  (256  + 64 * (j))
#define XB_XSUB(j)  (1280 + 64 * (j))
#define XB_XGEN(j)  (2304 + 64 * (j))
#define XB_TOP      3328
#define XB_TOPGEN   3392
#define XCD_BAR_WORDS 3456
#define XB_SPIN_CAP (1u << 18)

__device__ __forceinline__ unsigned xb_ld(unsigned* p)              { return __hip_atomic_load(p, __ATOMIC_RELAXED, __HIP_MEMORY_SCOPE_AGENT); }
__device__ __forceinline__ unsigned xb_add(unsigned* p, unsigned v) { return __hip_atomic_fetch_add(p, v, __ATOMIC_RELAXED, __HIP_MEMORY_SCOPE_AGENT); }
__device__ __forceinline__ unsigned xb_xcc_id() { return (unsigned)__builtin_amdgcn_s_getreg((3 << 11) | 20) & 0xFu; }
#define XB_SPIN(cond, bar) do { unsigned _sp = 0; while (cond) { __builtin_amdgcn_s_sleep(0); \
    if ((++_sp & 255u) == 0u) { if (xb_ld(&(bar)[XB_TMO])) break; if (_sp > XB_SPIN_CAP) { atomicAdd(&(bar)[XB_TMO], 1u); break; } } } } while (0)

struct XcdBarrier {
    unsigned* bar; unsigned x;
    volatile LAS unsigned* st;
};

__device__ __forceinline__ XcdBarrier xcd_barrier_post(unsigned* bar, volatile LAS unsigned* st) {
    XcdBarrier b; b.bar = bar; b.x = xb_xcc_id(); b.st = st;
    if (threadIdx.x == 0) (void)xb_add(&bar[XB_XCNT(b.x)], 1u);
    return b;
}
__device__ __forceinline__ void xcd_barrier_complete(unsigned* bar, unsigned x, unsigned& nloc, unsigned& nx) {
    const unsigned G = gridDim.x * gridDim.y * gridDim.z;
    unsigned sum, cnt, mine, sp = 0u;
    for (;;) {
        sum = 0u; cnt = 0u; mine = 0u;
#pragma unroll
        for (unsigned j = 0; j < 16; ++j) { const unsigned c = xb_ld(&bar[XB_XCNT(j)]); sum += c; cnt += (c > 0u) ? 1u : 0u; mine = (j == x) ? c : mine; }
        if (sum == G) break;
        __builtin_amdgcn_s_sleep(1);
        if ((++sp & 255u) == 0u) { if (xb_ld(&bar[XB_TMO])) break; if (sp > XB_SPIN_CAP) { atomicAdd(&bar[XB_TMO], 1u); break; } }
    }
    nloc = mine > 0u ? mine : 1u; nx = cnt > 0u ? cnt : 1u;
}

__device__ __forceinline__ void xcd_barrier(const XcdBarrier& b) {
    asm volatile("s_waitcnt vmcnt(0)" ::: "memory");
    __syncthreads();
    if (threadIdx.x == 0) {
        unsigned* bar = b.bar;
        __builtin_amdgcn_s_waitcnt(0);
        unsigned nloc = b.st[0], nx = b.st[1];
        if (nloc == 0u) { xcd_barrier_complete(bar, b.x, nloc, nx); b.st[0] = nloc; b.st[1] = nx; }
        const unsigned old = xb_add(&bar[XB_XSUB(b.x)], 1u);
        const unsigned gen = old / nloc;
        if (old + 1u == (gen + 1u) * nloc) {
            __builtin_amdgcn_fence(__ATOMIC_RELEASE, "agent");
            asm volatile("s_waitcnt vmcnt(0)" ::: "memory");
            const unsigned og = xb_add(&bar[XB_TOP], 1u);
            const unsigned tg = og / nx;
            if (og + 1u == (tg + 1u) * nx) xb_add(&bar[XB_TOPGEN], 1u);
            else XB_SPIN(xb_ld(&bar[XB_TOPGEN]) == tg, bar);
            __builtin_amdgcn_fence(__ATOMIC_ACQUIRE, "agent");
            xb_add(&bar[XB_XGEN(b.x)], 1u);
            asm volatile("s_waitcnt vmcnt(0)" ::: "memory");
        } else {
            XB_SPIN(xb_ld(&bar[XB_XGEN(b.x)]) == gen, bar);
            __builtin_amdgcn_fence(__ATOMIC_ACQUIRE, "agent");
            asm volatile("s_waitcnt vmcnt(0)" ::: "memory");
        }
    }
    __syncthreads();
}

constexpr int D = 1024, MP = 16384, MS = 2048, M = MP + MS, DFF = 2816, NUP = 2 * DFF, DIN = 3072, NSEQ = 40, NMOD = 9216;
constexpr int NWAVES = 8, NTHREADS = 512;
constexpr float EPS = 1e-6f;
constexpr float C2 = 0.125f * 1.4426950408889634f;
constexpr size_t O_YP = 0, O_YS = 16777216, O_KP = 18874368, O_VP = 35651584, O_SP = 52428800, O_KS = 52953088, O_VS = 55050240, O_SS = 57147392;
constexpr size_t MiB = 1u << 20;
constexpr size_t WS_CTL = 0, CTL_ZERO_BYTES = 64 * 1024;
constexpr size_t WS_MOD = 1 * MiB;
constexpr size_t WS_TRIG = 4 * MiB;
constexpr size_t WS_WUP = 8 * MiB;
constexpr size_t WS_WDN = 52 * MiB;
constexpr size_t WS_WIN = 74 * MiB;
constexpr size_t WS_WOUT = 86 * MiB;
constexpr size_t WS_H = 90 * MiB;
constexpr size_t WS_ACT = 126 * MiB;
constexpr size_t WS_MIX = 225 * MiB;
constexpr size_t WS_RQ = 261 * MiB;
constexpr size_t WS_RK = 270 * MiB;
constexpr size_t WS_RV = 279 * MiB;
constexpr size_t WS_SG = 297 * MiB;
constexpr size_t WS_DQ = 315 * MiB;
constexpr size_t WS_DK = 333 * MiB;
constexpr size_t WS_DV = 351 * MiB;
constexpr size_t WS_KV = 369 * MiB;
constexpr size_t WS_SC = 405 * MiB;
constexpr size_t WS_PART = 423 * MiB;
constexpr size_t WS_PARTD = 460 * MiB;
constexpr size_t WS_XB = 492 * MiB;
constexpr size_t WS_END = 528 * MiB;
constexpr int CW_BAR = 4096;
constexpr int RING_BYTES = 131072, MISC_OFF = RING_BYTES + 320, LDS_BYTES = 147456;

using pg8::Unit; using pg8::u32x4; using pg8::bf16_t;
typedef short s16x4 __attribute__((ext_vector_type(4)));
typedef float f32x16 __attribute__((ext_vector_type(16)));
typedef float f32x2v __attribute__((ext_vector_type(2)));
typedef __bf16 bf16x2_t __attribute__((ext_vector_type(2)));

__device__ __forceinline__ unsigned cvtpk(float lo, float hi) { f32x2v v = {lo, hi}; bf16x2_t b = __builtin_convertvector(v, bf16x2_t); return __builtin_bit_cast(unsigned, b); }
__device__ __forceinline__ float bf2f(unsigned short b) { return __builtin_bit_cast(float, (unsigned)b << 16); }
__device__ __forceinline__ float silu_f(float a) { return a * __builtin_amdgcn_rcpf(1.0f + __builtin_amdgcn_exp2f(-1.4426950408889634f * a)); }
__device__ __forceinline__ int row_sidx(int r) { return r < MP ? (r >> 11) : 8 + ((r - MP) >> 6); }
__device__ __forceinline__ int row_tidx(int r) { return r < MP ? (r & 2047) : 2048 + (r & 63); }
template <int CTRL> __device__ __forceinline__ float dpp_f(float v) { return __builtin_bit_cast(float, __builtin_amdgcn_update_dpp(0, __builtin_bit_cast(int, v), CTRL, 0xF, 0xF, true)); }
__device__ __forceinline__ void swap16(unsigned& a, unsigned& b) { asm volatile("s_nop 1\n\tv_permlane16_swap_b32 %0, %1" : "+v"(a), "+v"(b)); }
__device__ __forceinline__ void swap32(unsigned& a, unsigned& b) { asm volatile("s_nop 1\n\tv_permlane32_swap_b32 %0, %1" : "+v"(a), "+v"(b)); }
__device__ __forceinline__ float xor16_sum(float v) { unsigned a = __builtin_bit_cast(unsigned, v), b = a; swap16(a, b); return __builtin_bit_cast(float, a) + __builtin_bit_cast(float, b); }
__device__ __forceinline__ float xor32_sum(float v) { unsigned a = __builtin_bit_cast(unsigned, v), b = a; swap32(a, b); return __builtin_bit_cast(float, a) + __builtin_bit_cast(float, b); }
__device__ __forceinline__ float xor16_max(float v) { unsigned a = __builtin_bit_cast(unsigned, v), b = a; swap16(a, b); return fmaxf(__builtin_bit_cast(float, a), __builtin_bit_cast(float, b)); }
__device__ __forceinline__ float xor32_max(float v) { unsigned a = __builtin_bit_cast(unsigned, v), b = a; swap32(a, b); return fmaxf(__builtin_bit_cast(float, a), __builtin_bit_cast(float, b)); }
__device__ __forceinline__ float wave_sum(float v) {
    v += dpp_f<0xB1>(v); v += dpp_f<0x4E>(v);
    v += dpp_f<0x124>(v); v += dpp_f<0x128>(v);
    return xor32_sum(xor16_sum(v));
}
__device__ __forceinline__ float wave_max(float v) {
    v = fmaxf(v, dpp_f<0xB1>(v)); v = fmaxf(v, dpp_f<0x4E>(v));
    v = fmaxf(v, dpp_f<0x124>(v)); v = fmaxf(v, dpp_f<0x128>(v));
    return xor32_max(xor16_max(v));
}
__device__ __forceinline__ unsigned off_b(unsigned row, unsigned ch) { return 256u * row + 16u * (ch ^ (((row & 3u) << 2) | ((row >> 2) & 3u))); }
__device__ __forceinline__ unsigned tr_addr(unsigned lane, unsigned R0, unsigned c) {
    const unsigned blk = (lane >> 4) & 1u, q = (lane & 15u) >> 2, p = lane & 3u;
    return off_b(R0 + q, 4u * c + 2u * blk + (p >> 1)) + 8u * (p & 1u);
}
__device__ __forceinline__ s16x4 ds_tr(LAS unsigned char* base, unsigned off) {
    return __builtin_bit_cast(s16x4, __builtin_amdgcn_ds_read_tr16_b64_v4i16((LAS s16x4*)(base + off)));
}
__device__ __forceinline__ bf16x8 cat8(s16x4 lo, s16x4 hi) { return (bf16x8){lo[0], lo[1], lo[2], lo[3], hi[0], hi[1], hi[2], hi[3]}; }
#define MFMA32(a, b, c) __builtin_amdgcn_mfma_f32_32x32x16_bf16((a), (b), (c), 0, 0, 0)
__device__ __forceinline__ int crow(int r, int hi) { return (r & 3) + 8 * (r >> 2) + 4 * hi; }
__device__ __forceinline__ bf16x8 pack_step(const f32x16& x, int s) {
    u32x4 p; p[0] = cvtpk(x[8 * s], x[8 * s + 1]); p[1] = cvtpk(x[8 * s + 2], x[8 * s + 3]); p[2] = cvtpk(x[8 * s + 4], x[8 * s + 5]); p[3] = cvtpk(x[8 * s + 6], x[8 * s + 7]);
    return __builtin_bit_cast(bf16x8, p);
}

struct EpiUp {
    static constexpr bool PERM = true, AFTER_DRAIN = false;
    bf16_t* act;
    __device__ __forceinline__ void operator()(const f32x4 (&acc)[2][2][4][2], const Unit& u, int wr, int wc, int fr, int fq) const {
        asm volatile("" : "+v"(fr), "+v"(fq));
        const int row0 = u.pm * 256 + (u.half == 2 ? 128 : 0) + wr * 64 + fr, col = u.pn * 128 + wc * 32 + 8 * fq;
#pragma unroll
        for (int ai = 0; ai < 2; ++ai) {
            if (ai == 1 && u.half) break;
#pragma unroll
            for (int m = 0; m < 4; ++m) {
                const int row = row0 + ai * 128 + m * 16;
                float o[8];
#pragma unroll
                for (int n = 0; n < 2; ++n)
#pragma unroll
                    for (int e = 0; e < 4; ++e) o[4 * n + e] = silu_f(acc[ai][0][m][n][e]) * acc[ai][1][m][n][e];
                u32x4 w; w.x = cvtpk(o[0], o[1]); w.y = cvtpk(o[2], o[3]); w.z = cvtpk(o[4], o[5]); w.w = cvtpk(o[6], o[7]);
                *(u32x4*)(act + (size_t)row * DFF + col) = w;
                asm volatile("" ::: "memory");
            }
        }
    }
};
struct EpiRes {
    static constexpr bool PERM = true, AFTER_DRAIN = false;
    bf16_t* XB; float* yout; int fin; const float* gate; float fac; bf16_t* partd;
    __device__ __forceinline__ void operator()(const f32x4 (&acc)[2][2][4][2], const Unit& u, int wr, int wc, int fr, int fq) const {
        asm volatile("" : "+v"(fr), "+v"(fq));
        const int row0 = u.pm * 256 + (u.half == 2 ? 128 : 0) + wr * 64 + fr, col0 = u.pn * 256 + wc * 32 + 8 * fq;
        if (u.pm >= 64) {
#pragma unroll
            for (int ai = 0; ai < 2; ++ai)
#pragma unroll
                for (int m = 0; m < 4; ++m) {
                    if (ai == 1 && u.half) continue;
                    const int row = row0 + ai * 128 + m * 16;
                    bf16_t* po = partd + ((size_t)u.aux * MS + (row - MP)) * D + col0;
#pragma unroll
                    for (int bj = 0; bj < 2; ++bj) { const f32x4 p0 = acc[ai][bj][m][0], p1 = acc[ai][bj][m][1];
                        u32x4 w; w.x = cvtpk(p0[0], p0[1]); w.y = cvtpk(p0[2], p0[3]); w.z = cvtpk(p1[0], p1[1]); w.w = cvtpk(p1[2], p1[3]); *(u32x4*)(po + bj * 128) = w; }
                }
            return;
        }
        const float* g = gate + (size_t)((u.pm * 256) >> 11) * NMOD + col0;
#pragma unroll
        for (int ai = 0; ai < 2; ++ai)
#pragma unroll
            for (int bj = 0; bj < 2; ++bj) {
                f32x4 gv[2]; u32x4 xb[4];
#pragma unroll
                for (int n = 0; n < 2; ++n) gv[n] = *(const f32x4*)(g + bj * 128 + n * 4);
#pragma unroll
                for (int m = 0; m < 4; ++m) { const size_t off = (size_t)(row0 + ai * 128 + m * 16) * D + col0 + bj * 128;
                    xb[m] = *(const u32x4*)(XB + off); }
#pragma unroll
                for (int m = 0; m < 4; ++m) { const size_t off = (size_t)(row0 + ai * 128 + m * 16) * D + col0 + bj * 128;
                    f32x4 x0, x1;
                    { x0 = (f32x4){__builtin_bit_cast(float, xb[m][0] << 16), __builtin_bit_cast(float, xb[m][0] & 0xffff0000u), __builtin_bit_cast(float, xb[m][1] << 16), __builtin_bit_cast(float, xb[m][1] & 0xffff0000u)};
                           x1 = (f32x4){__builtin_bit_cast(float, xb[m][2] << 16), __builtin_bit_cast(float, xb[m][2] & 0xffff0000u), __builtin_bit_cast(float, xb[m][3] << 16), __builtin_bit_cast(float, xb[m][3] & 0xffff0000u)}; }
                    const f32x4 y0 = x0 + (gv[0] * fac) * acc[ai][bj][m][0], y1 = x1 + (gv[1] * fac) * acc[ai][bj][m][1];
                    if (fin) { __builtin_nontemporal_store(y0, (f32x4*)(yout + off)); __builtin_nontemporal_store(y1, (f32x4*)(yout + off + 4)); }
                    else { u32x4 w; w.x = cvtpk(y0[0], y0[1]); w.y = cvtpk(y0[2], y0[3]); w.z = cvtpk(y1[0], y1[1]); w.w = cvtpk(y1[2], y1[3]); *(u32x4*)(XB + off) = w; } }
                asm volatile("" ::: "memory");
            }
    }
};
struct TailOrder {
    pg8::StaticOrder P; int G, c, nfull, rem;
    __device__ __forceinline__ void init(int M_, int N_, int G_, int c_) { P.init(M_, N_, G_, c_); G = G_; c = c_; nfull = P.nwg / G_; rem = P.nwg - nfull * G_; }
    __device__ __forceinline__ bool next(int i, Unit& u) const {
        if (i < nfull) return P.next(i, u);
        const int hL = (i - nfull) * G + c; if (hL >= 2 * rem) return false;
        const bool ok = P.at((long)nfull * G + (hL >> 1), u); u.half = 1 + (hL & 1); return ok;
    }
    __device__ __forceinline__ void a_ready(const Unit&) const {}
    __device__ __forceinline__ void done(const Unit&) const {}
};
struct SplitOrder {
    pg8::StaticOrder P; int G, c, np, kt;
    __device__ __forceinline__ void init(int G_, int c_, int ktiles) { P.init(MP, D, G_, c_); G = G_; c = c_; np = (256 + G_ - 1) / G_; kt = ktiles; }
    __device__ __forceinline__ bool next(int i, Unit& u) const {
        const int cnt_p = c < 256 ? (256 - c + G - 1) / G : 0;
        const bool isp = i < cnt_p;
        Unit a; const bool oka = P.at((long)(isp ? i : 0) * G + c, a);
        const int q = (i - cnt_p) * G + c;
        const int sp = q & 7; const bool big = kt == 44; const int step = big ? 6 : 2;
        int kt0 = step * sp; if (big && kt0 > 40) kt0 = 40;
        int nkt = step; if (big && sp >= 6) nkt = 4;
        u.pm = isp ? a.pm : 64 + ((q >> 5) & 7); u.pn = isp ? a.pn : (q >> 3) & 3; u.kt0 = isp ? 0 : kt0; u.nkt = isp ? 0 : nkt; u.aux = isp ? 0 : sp; u.half = 0;
        return isp ? oka : (q >= 0 && q < 256);
    }
    __device__ __forceinline__ void a_ready(const Unit&) const {}
    __device__ __forceinline__ void done(const Unit&) const {}
};
struct EpiIn {
    static constexpr bool PERM = true, AFTER_DRAIN = false;
    bf16_t *RQ, *RK, *RV, *SG, *DQ, *DK, *DV; float *kout_p, *kout_s, *vout_p, *vout_s;
    const float* gqk;
    __device__ __forceinline__ void operator()(const f32x4 (&acc)[2][2][4][2], const Unit& u, int wr, int wc, int fr, int fq) const {
        asm volatile("" : "+v"(fr), "+v"(fq));
        const int row0 = u.pm * 256 + (u.half == 2 ? 128 : 0) + wr * 64 + fr; const int pn = u.pn; const int nai = u.half ? 1 : 2;
        if (pn <= 1) {
            bf16_t* O = pn == 0 ? RQ : RK;
#pragma unroll
            for (int bj = 0; bj < 2; ++bj) {
                const int head = 2 * bj + (wc >> 1);
                const float lg = log2f(1.0f - exp2f(-5.0f - (float)head));
                const int i0 = 16 * (wc & 1) + 4 * fq;
                float rf[4];
#pragma unroll
                for (int k = 0; k < 4; ++k) rf[k] = exp2f(-(float)(i0 + k) * (13.287712379549449f / 31.0f) - 2.651496129472319f);
#pragma unroll
                for (int ai = 0; ai < 2; ++ai)
#pragma unroll
                    for (int m = 0; m < 4; ++m) { if (ai >= nai) continue;
                        const int row = row0 + ai * 128 + m * 16;
                        const float posf = (float)(row < MP ? (row & 2047) : 4096 + (row & 63));
                        float cs[4], sn[4];
#pragma unroll
                        for (int k = 0; k < 4; ++k) { float r = posf * rf[k]; r = r - floorf(r); cs[k] = __builtin_amdgcn_cosf(r); sn[k] = __builtin_amdgcn_sinf(r); }
                        const float ic1 = (float)((row & 63) + 1);
                        const float sc = pn == 0 ? exp2f(lg * ic1) : 0.125f * exp2f(-lg * ic1);
                        const f32x4 v0 = acc[ai][bj][m][0], v1 = acc[ai][bj][m][1];
                        float o[8];
                        o[0] = (v0[0] * cs[0] - v0[1] * sn[0]) * sc; o[1] = (v0[0] * sn[0] + v0[1] * cs[0]) * sc;
                        o[2] = (v0[2] * cs[1] - v0[3] * sn[1]) * sc; o[3] = (v0[2] * sn[1] + v0[3] * cs[1]) * sc;
                        o[4] = (v1[0] * cs[2] - v1[1] * sn[2]) * sc; o[5] = (v1[0] * sn[2] + v1[1] * cs[2]) * sc;
                        o[6] = (v1[2] * cs[3] - v1[3] * sn[3]) * sc; o[7] = (v1[2] * sn[3] + v1[3] * cs[3]) * sc;
                        u32x4 w; w.x = cvtpk(o[0], o[1]); w.y = cvtpk(o[2], o[3]); w.z = cvtpk(o[4], o[5]); w.w = cvtpk(o[6], o[7]);
                        *(u32x4*)(O + ((size_t)(((row >> 6) * 4 + head) * 8 + ((row & 63) >> 5) * 4 + 2 * (wc & 1) + (fq >> 1)) * 512 + (size_t)((row & 31) + 32 * (fq & 1)) * 8)) = w;
                    }
            }
        } else if (pn <= 5) {
            bf16_t* O = pn <= 3 ? RV : SG; const int cb = 256 * ((pn - 2) & 1);
#pragma unroll
            for (int ai = 0; ai < 2; ++ai)
#pragma unroll
                for (int m = 0; m < 4; ++m) { if (ai >= nai) continue;
                    const int row = row0 + ai * 128 + m * 16;
#pragma unroll
                    for (int bj = 0; bj < 2; ++bj) {
                        f32x4 v0 = acc[ai][bj][m][0], v1 = acc[ai][bj][m][1];
                        if (pn >= 4) {
#pragma unroll
                            for (int e = 0; e < 4; ++e) { v0[e] = silu_f(v0[e]); v1[e] = silu_f(v1[e]); }
                        }
                        u32x4 w; w.x = cvtpk(v0[0], v0[1]); w.y = cvtpk(v0[2], v0[3]); w.z = cvtpk(v1[0], v1[1]); w.w = cvtpk(v1[2], v1[3]);
                        *(u32x4*)(O + (size_t)row * 512 + cb + 128 * bj + 32 * wc + 8 * fq) = w;
                    }
                    asm volatile("" ::: "memory");
                }
        } else if (pn <= 9) {
            const bool isq = pn <= 7; const int cb = 256 * ((pn - 6) & 1) + 64 * wc;
            const float* g = gqk + (isq ? 0 : 64);
            float rf[8];
#pragma unroll
            for (int k = 0; k < 8; ++k) rf[k] = exp2f(-(float)(8 * fq + k) * (13.287712379549449f / 32.0f) - 2.651496129472319f);
            const f32x4 g00 = *(const f32x4*)(g + 8 * fq), g01 = *(const f32x4*)(g + 8 * fq + 4), g10 = *(const f32x4*)(g + 32 + 8 * fq), g11 = *(const f32x4*)(g + 32 + 8 * fq + 4);
#pragma unroll
            for (int ai = 0; ai < 2; ++ai)
#pragma unroll
                for (int m = 0; m < 4; ++m) { if (ai >= nai) continue;
                    const int row = row0 + ai * 128 + m * 16;
                    const f32x4 a0 = acc[ai][0][m][0], a1 = acc[ai][0][m][1], b0 = acc[ai][1][m][0], b1 = acc[ai][1][m][1];
                    float ss = 0.f;
#pragma unroll
                    for (int e = 0; e < 4; ++e) ss += a0[e] * a0[e] + a1[e] * a1[e] + b0[e] * b0[e] + b1[e] * b1[e];
                    ss = xor32_sum(xor16_sum(ss));
                    float rs = 1.0f / sqrtf(ss * (1.0f / 64.0f) + EPS);
                    const float posf = (float)(row < MP ? (row & 2047) : 4096 + (row & 63));
                    float cs[8], sn[8];
#pragma unroll
                    for (int k = 0; k < 8; ++k) { float r = posf * rf[k]; r = r - floorf(r); cs[k] = __builtin_amdgcn_cosf(r); sn[k] = __builtin_amdgcn_sinf(r); }
                    float x1[8], x2[8], o1[8], o2[8];
#pragma unroll
                    for (int e = 0; e < 4; ++e) { x1[e] = a0[e] * rs * g00[e]; x1[4 + e] = a1[e] * rs * g01[e]; x2[e] = b0[e] * rs * g10[e]; x2[4 + e] = b1[e] * rs * g11[e]; }
                    const float osc = isq ? C2 : 1.0f;
#pragma unroll
                    for (int j = 0; j < 8; ++j) { o1[j] = (x1[j] * cs[j] - x2[j] * sn[j]) * osc; o2[j] = (x2[j] * cs[j] + x1[j] * sn[j]) * osc; }
                    bf16_t* O = (isq ? DQ : DK) + (size_t)row * 512 + cb + 8 * fq;
                    u32x4 w; w.x = cvtpk(o1[0], o1[1]); w.y = cvtpk(o1[2], o1[3]); w.z = cvtpk(o1[4], o1[5]); w.w = cvtpk(o1[6], o1[7]);
                    *(u32x4*)O = w;
                    w.x = cvtpk(o2[0], o2[1]); w.y = cvtpk(o2[2], o2[3]); w.z = cvtpk(o2[4], o2[5]); w.w = cvtpk(o2[6], o2[7]);
                    *(u32x4*)(O + 32) = w;
                    if (!isq) {
                        float* ko = (row < MP ? kout_p + (size_t)row * 512 : kout_s + (size_t)(row - MP) * 512) + cb + 8 * fq;
                        __builtin_nontemporal_store((f32x4){o1[0], o1[1], o1[2], o1[3]}, (f32x4*)ko); __builtin_nontemporal_store((f32x4){o1[4], o1[5], o1[6], o1[7]}, (f32x4*)(ko + 4));
                        __builtin_nontemporal_store((f32x4){o2[0], o2[1], o2[2], o2[3]}, (f32x4*)(ko + 32)); __builtin_nontemporal_store((f32x4){o2[4], o2[5], o2[6], o2[7]}, (f32x4*)(ko + 36));
                    }
                    asm volatile("" ::: "memory");
                }
        } else {
            const int cb = 256 * ((pn - 10) & 1);
#pragma unroll
            for (int ai = 0; ai < 2; ++ai)
#pragma unroll
                for (int m = 0; m < 4; ++m) { if (ai >= nai) continue;
                    const int row = row0 + ai * 128 + m * 16;
                    float* vo = (row < MP ? vout_p + (size_t)row * 512 : vout_s + (size_t)(row - MP) * 512) + cb;
#pragma unroll
                    for (int bj = 0; bj < 2; ++bj) {
                        const int c = 128 * bj + 32 * wc + 8 * fq;
                        const f32x4 v0 = acc[ai][bj][m][0], v1 = acc[ai][bj][m][1];
                        __builtin_nontemporal_store(v0, (f32x4*)(vo + c)); __builtin_nontemporal_store(v1, (f32x4*)(vo + c + 4));
                        u32x4 w; w.x = cvtpk(v0[0], v0[1]); w.y = cvtpk(v0[2], v0[3]); w.z = cvtpk(v1[0], v1[1]); w.w = cvtpk(v1[2], v1[3]);
                        *(u32x4*)(DV + (size_t)row * 512 + cb + c) = w;
                    }
                    asm volatile("" ::: "memory");
                }
        }
    }
};

__device__ __forceinline__ void transpose_item(const float* __restrict__ W, int K, int N, bf16_t* __restrict__ WT, int dst_row0, int src_col0, int k0, LAS float* scr, int lane, bool far = false) {
    float t[32];
    const float* wp = W + (size_t)(k0 + (lane >> 5)) * N + src_col0 + (lane & 31);
#pragma unroll
    for (int i = 0; i < 32; ++i) t[i] = __builtin_nontemporal_load(wp + (size_t)(2 * i) * N);
#pragma unroll
    for (int i = 0; i < 32; ++i) scr[(2 * i + (lane >> 5)) * 33 + (lane & 31)] = t[i];
    LDS_WAIT(); asm volatile("" ::: "memory");
    const int c = lane & 7;
#pragma unroll
    for (int j = 0; j < 4; ++j) { const int n = (lane >> 3) + 8 * j; const LAS float* s = scr + (8 * c) * 33 + n;
        v4u o; o.x = pk2(s[0 * 33], s[1 * 33]); o.y = pk2(s[2 * 33], s[3 * 33]); o.z = pk2(s[4 * 33], s[5 * 33]); o.w = pk2(s[6 * 33], s[7 * 33]);
        if (far) __builtin_nontemporal_store(o, (GAS v4u*)(WT + (size_t)(dst_row0 + n) * K + k0 + 8 * c)); else *(GAS v4u*)(WT + (size_t)(dst_row0 + n) * K + k0 + 8 * c) = o; }
    LDS_WAIT(); asm volatile("" ::: "memory");
}
constexpr int I_UP = 16 * 176, I_DN = 44 * 32, I_IN = 16 * 96, I_OUT = 16 * 32, I_LAYER = 2 * I_UP + 2 * I_DN + I_IN + I_OUT;
__device__ __forceinline__ void convert_layer_item(int lay, int j, const float* w_ff_up, const float* w_ff_down, const float* w_in, const float* w_out, unsigned char* ws, LAS float* scr, int lane) {
    int r = j;
    if (r < 2 * I_UP) { const int mat = lay * 2 + r / I_UP; r %= I_UP; const int kb = r / 176, g = r % 176;
        const int pn = g >> 3, bj = (g >> 2) & 1, wc = g & 3;
        transpose_item(w_ff_up + (size_t)mat * D * NUP, D, NUP, (bf16_t*)(ws + WS_WUP) + (size_t)mat * NUP * D, 32 * g, (bj ? DFF : 0) + 128 * pn + 32 * wc, 64 * kb, scr, lane, lay == 1); return; }
    r -= 2 * I_UP;
    if (r < 2 * I_DN) { const int mat = lay * 2 + r / I_DN; r %= I_DN; const int kb = r / 32, g = r % 32;
        transpose_item(w_ff_down + (size_t)mat * DFF * D, DFF, D, (bf16_t*)(ws + WS_WDN) + (size_t)mat * D * DFF, 32 * g, 32 * g, 64 * kb, scr, lane, lay == 1); return; }
    r -= 2 * I_DN;
    if (r < I_IN) { const int kb = r / 96, g = r % 96;
        const int pn = g >> 3, bj = (g >> 2) & 1, wc = g & 3;
        const int src = (pn >= 6 && pn <= 9) ? 256 * pn + 64 * wc + 32 * bj : 32 * g;
        transpose_item(w_in + (size_t)lay * D * DIN, D, DIN, (bf16_t*)(ws + WS_WIN) + (size_t)lay * DIN * D, 32 * g, src, 64 * kb, scr, lane, lay == 1); return; }
    r -= I_IN;
    { const int kb = r / 32, g = r % 32;
        transpose_item(w_out + (size_t)lay * D * D, D, D, (bf16_t*)(ws + WS_WOUT) + (size_t)lay * D * D, 32 * g, 32 * g, 64 * kb, scr, lane, lay == 1); }
}
__device__ __forceinline__ void background_convert(int jb, int je, int rank, int nidle, int wid, const float* w_ff_up, const float* w_ff_down, const float* w_in, const float* w_out, unsigned char* ws, LAS unsigned char* lds, int lane) {
    if (rank < 0) return;
    LAS float* scr = (LAS float*)(lds + wid * 16384);
#pragma unroll 1
    for (int j = jb + rank * NWAVES + wid; j < je; j += nidle * NWAVES) convert_layer_item(1, j, w_ff_up, w_ff_down, w_in, w_out, ws, scr, lane);
}
__device__ __forceinline__ void adaln_item(int item, const float* cp, const float* cs, const float* w_ada, const float* b_ada, float* mod, LAS unsigned char* lds, int tid, int wid, int lane) {
    const int l = item / 144, cg = item % 144, fr = lane & 15, fq = lane >> 4, kb0 = wid * 128;
    LAS unsigned char* Tw = lds + wid * 13312;
    const __amdgpu_buffer_rsrc_t cprs = __builtin_amdgcn_make_buffer_rsrc((void*)cp, 0, 8 * D * 4, 0x00020000), csrs = __builtin_amdgcn_make_buffer_rsrc((void*)cs, 0, 32 * D * 4, 0x00020000);
    const unsigned loff = (unsigned)lane * 4u;
#pragma unroll
    for (int s = 0; s < 40; ++s)
#pragma unroll
        for (int h = 0; h < 2; ++h) { const float c = __builtin_bit_cast(float, __builtin_amdgcn_raw_buffer_load_b32(s < 8 ? cprs : csrs, loff, (unsigned)(((s < 8 ? s : s - 8) * D + kb0 + 64 * h) * 4), 0));
            *(LAS unsigned short*)(Tw + s * 272 + (64 * h + lane) * 2) = (unsigned short)f2bf(c / (1.0f + __expf(-c))); }
    const __amdgpu_buffer_rsrc_t wrs = __builtin_amdgcn_make_buffer_rsrc((void*)w_ada, 0, 2 * D * NMOD * 4, 0x00020000);
    const unsigned voff = (unsigned)((8 * fq) * NMOD + fr) * 4u;
    f32x4 acc[4][3];
#pragma unroll
    for (int nb = 0; nb < 4; ++nb)
#pragma unroll
        for (int sb = 0; sb < 3; ++sb) acc[nb][sb] = (f32x4){0.f, 0.f, 0.f, 0.f};
    LDS_WAIT(); asm volatile("" ::: "memory");
#pragma unroll
    for (int kb = 0; kb < 4; ++kb) {
        bf16x8 yf[4];
#pragma unroll
        for (int nb = 0; nb < 4; ++nb) {
            float w[8];
#pragma unroll
            for (int j = 0; j < 8; ++j) w[j] = __builtin_bit_cast(float, __builtin_amdgcn_raw_buffer_load_b32(wrs, voff, (unsigned)((l * D + kb0 + 32 * kb + j) * NMOD + cg * 64 + 16 * nb) * 4u,   2));
            u32x4 pk; pk.x = cvtpk(w[0], w[1]); pk.y = cvtpk(w[2], w[3]); pk.z = cvtpk(w[4], w[5]); pk.w = cvtpk(w[6], w[7]);
            yf[nb] = __builtin_bit_cast(bf16x8, pk);
        }
        bf16x8 xf[3];
#pragma unroll
        for (int sb = 0; sb < 3; ++sb) xf[sb] = *(const LAS bf16x8*)(Tw + (16 * sb + fr) * 272 + (32 * kb + 8 * fq) * 2);
#pragma unroll
        for (int nb = 0; nb < 4; ++nb)
#pragma unroll
            for (int sb = 0; sb < 3; ++sb) acc[nb][sb] = __builtin_amdgcn_mfma_f32_16x16x32_bf16(xf[sb], yf[nb], acc[nb][sb], 0, 0, 0);
    }
    __syncthreads();
    LAS float* R = (LAS float*)lds;
#pragma unroll
    for (int nb = 0; nb < 4; ++nb)
#pragma unroll
        for (int sb = 0; sb < 3; ++sb)
#pragma unroll
            for (int e = 0; e < 4; ++e) { const int s = 16 * sb + 4 * fq + e; if (s < 40) R[(wid * 40 + s) * 64 + 16 * nb + fr] = acc[nb][sb][e]; }
    __syncthreads();
    for (int idx = tid; idx < 40 * 64; idx += NTHREADS) {
        const int s = idx >> 6, ln = idx & 63; float v = b_ada[(size_t)l * NMOD + cg * 64 + ln];
#pragma unroll
        for (int w = 0; w < 8; ++w) v += R[(w * 40 + s) * 64 + ln];
        mod[((size_t)l * NSEQ + s) * NMOD + cg * 64 + ln] = v;
    }
    __syncthreads();
}
__device__ __forceinline__ void trig_fill(float* trig, int gtid, int gthreads) {
    for (int i = gtid; i < 2112 * 64; i += gthreads) {
        const int pidx = i >> 6, kind = (i >> 5) & 1, j = i & 31;
        const int pos = pidx < 2048 ? pidx : 4096 + (pidx - 2048);
        const double ex = kind == 0 ? (double)j / 31.0 : (double)j / 32.0;
        const float invf = (float)exp2(-ex * 13.287712379549449);
        const float ang = (float)pos * invf;
        const double rev = (double)ang * 0.15915494309189535; const float fr = (float)(rev - floor(rev));
        trig[2 * i] = __builtin_amdgcn_cosf(fr); trig[2 * i + 1] = __builtin_amdgcn_sinf(fr);
    }
}
__device__ __forceinline__ void norm_row_store(const f32x4 (&v)[2][2], const f32x4 (&gv)[2][2], const f32x4 (&sh)[2][2], const f32x4 (&sc1)[2][2], bf16_t* Hrow, int lane) {
    float ss = 0.f;
#pragma unroll
    for (int j = 0; j < 2; ++j)
#pragma unroll
        for (int q = 0; q < 2; ++q) ss += (v[j][q][0] * v[j][q][0] + v[j][q][1] * v[j][q][1]) + (v[j][q][2] * v[j][q][2] + v[j][q][3] * v[j][q][3]);
    const float rs = 1.0f / sqrtf(wave_sum(ss) * (1.0f / D) + EPS);
#pragma unroll
    for (int j = 0; j < 2; ++j) {
        const f32x4 y0 = (v[j][0] * rs) * gv[j][0] * sc1[j][0] + sh[j][0], y1 = (v[j][1] * rs) * gv[j][1] * sc1[j][1] + sh[j][1];
        u32x4 w; w.x = cvtpk(y0[0], y0[1]); w.y = cvtpk(y0[2], y0[3]); w.z = cvtpk(y1[0], y1[1]); w.w = cvtpk(y1[2], y1[3]);
        *(u32x4*)(Hrow + 8 * lane + 512 * j) = w;
    }
}
__device__ __forceinline__ void norm_phase(const float* fp, const float* fs, bf16_t* XB, const float* g, const float* mod_l, int sub, bf16_t* H, int gw, int ngw, int lane,
                                           const bf16_t* partd, const float* pgate, float pfac) {
    f32x4 gv[2][2], sh[2][2], sc1[2][2];
#pragma unroll
    for (int j = 0; j < 2; ++j)
#pragma unroll
        for (int q = 0; q < 2; ++q) gv[j][q] = *(const f32x4*)(g + 8 * lane + 512 * j + 4 * q);
    {
        const int wps = ngw >> 3, seq = gw / wps, idx = gw - seq * wps;
        const float* md = mod_l + (size_t)seq * NMOD + sub * 3 * D + 8 * lane;
#pragma unroll
        for (int j = 0; j < 2; ++j)
#pragma unroll
            for (int q = 0; q < 2; ++q) { sh[j][q] = *(const f32x4*)(md + 512 * j + 4 * q); sc1[j][q] = *(const f32x4*)(md + D + 512 * j + 4 * q) + 1.0f; }
#define NORM_LOAD_ROW(v_, r_) do { _Pragma("unroll") for (int j = 0; j < 2; ++j) { const int c = 8 * lane + 512 * j; \
            if (fp) { v_[j][0] = __builtin_nontemporal_load((const f32x4*)(fp + (size_t)(r_) * D + c)); v_[j][1] = __builtin_nontemporal_load((const f32x4*)(fp + (size_t)(r_) * D + c + 4)); }     \
            else { const u32x4 b = *(const u32x4*)(XB + (size_t)(r_) * D + c); \
                v_[j][0] = (f32x4){__builtin_bit_cast(float, b[0] << 16), __builtin_bit_cast(float, b[0] & 0xffff0000u), __builtin_bit_cast(float, b[1] << 16), __builtin_bit_cast(float, b[1] & 0xffff0000u)}; \
                v_[j][1] = (f32x4){__builtin_bit_cast(float, b[2] << 16), __builtin_bit_cast(float, b[2] & 0xffff0000u), __builtin_bit_cast(float, b[3] << 16), __builtin_bit_cast(float, b[3] & 0xffff0000u)}; } } } while (0)
#define NORM_XB_STORE(v_, r_) do { if (fp) { _Pragma("unroll") for (int j = 0; j < 2; ++j) { u32x4 w; w.x = cvtpk(v_[j][0][0], v_[j][0][1]); w.y = cvtpk(v_[j][0][2], v_[j][0][3]); w.z = cvtpk(v_[j][1][0], v_[j][1][1]); w.w = cvtpk(v_[j][1][2], v_[j][1][3]); \
            *(u32x4*)(XB + (size_t)(r_) * D + 8 * lane + 512 * j) = w; } } } while (0)
#pragma unroll 1
        for (int t = idx; t < 2048; t += 2 * wps) {
            const int ra = seq * 2048 + t, rb = ra + wps; const bool hb = t + wps < 2048;
            f32x4 va[2][2], vb[2][2];
            NORM_LOAD_ROW(va, ra); NORM_LOAD_ROW(vb, hb ? rb : ra);
            NORM_XB_STORE(va, ra); norm_row_store(va, gv, sh, sc1, H + (size_t)ra * D, lane);
            if (hb) { NORM_XB_STORE(vb, rb); norm_row_store(vb, gv, sh, sc1, H + (size_t)rb * D, lane); }
        }
#undef NORM_LOAD_ROW
#undef NORM_XB_STORE
    }
    for (int r = MP + gw; r < M; r += ngw) {
        const float* xf = fs ? fs + (size_t)(r - MP) * D : nullptr;
        const int sidx = row_sidx(r);
        const float* md = mod_l + (size_t)sidx * NMOD + sub * 3 * D + 8 * lane;
#pragma unroll
        for (int j = 0; j < 2; ++j)
#pragma unroll
            for (int q = 0; q < 2; ++q) { sh[j][q] = *(const f32x4*)(md + 512 * j + 4 * q); sc1[j][q] = *(const f32x4*)(md + D + 512 * j + 4 * q) + 1.0f; }
        f32x4 v[2][2];
#pragma unroll
        for (int j = 0; j < 2; ++j) {
            const int c = 8 * lane + 512 * j;
            if (xf) { v[j][0] = __builtin_nontemporal_load((const f32x4*)(xf + c)); v[j][1] = __builtin_nontemporal_load((const f32x4*)(xf + c + 4));
                u32x4 w; w.x = cvtpk(v[j][0][0], v[j][0][1]); w.y = cvtpk(v[j][0][2], v[j][0][3]); w.z = cvtpk(v[j][1][0], v[j][1][1]); w.w = cvtpk(v[j][1][2], v[j][1][3]);
                *(u32x4*)(XB + (size_t)r * D + c) = w; }
            else { const u32x4 b = *(const u32x4*)(XB + (size_t)r * D + c);
                v[j][0] = (f32x4){__builtin_bit_cast(float, b[0] << 16), __builtin_bit_cast(float, b[0] & 0xffff0000u), __builtin_bit_cast(float, b[1] << 16), __builtin_bit_cast(float, b[1] & 0xffff0000u)};
                v[j][1] = (f32x4){__builtin_bit_cast(float, b[2] << 16), __builtin_bit_cast(float, b[2] & 0xffff0000u), __builtin_bit_cast(float, b[3] << 16), __builtin_bit_cast(float, b[3] & 0xffff0000u)}; }
        }
        if (partd != nullptr) {
            const bf16_t* pp = partd + (size_t)(r - MP) * D + 8 * lane; const float* pg = pgate + (size_t)sidx * NMOD + 8 * lane;
#pragma unroll
            for (int j = 0; j < 2; ++j) {
                u32x4 pb[8];
#pragma unroll
                for (int k = 0; k < 8; ++k) pb[k] = *(const u32x4*)(pp + (size_t)k * MS * D + 512 * j);
                f32x4 s0 = {0.f, 0.f, 0.f, 0.f}, s1 = {0.f, 0.f, 0.f, 0.f};
#pragma unroll
                for (int k = 0; k < 8; ++k) {
                    s0 = s0 + (f32x4){__builtin_bit_cast(float, pb[k][0] << 16), __builtin_bit_cast(float, pb[k][0] & 0xffff0000u), __builtin_bit_cast(float, pb[k][1] << 16), __builtin_bit_cast(float, pb[k][1] & 0xffff0000u)};
                    s1 = s1 + (f32x4){__builtin_bit_cast(float, pb[k][2] << 16), __builtin_bit_cast(float, pb[k][2] & 0xffff0000u), __builtin_bit_cast(float, pb[k][3] << 16), __builtin_bit_cast(float, pb[k][3] & 0xffff0000u)}; }
                v[j][0] = v[j][0] + (*(const f32x4*)(pg + 512 * j) * pfac) * s0; v[j][1] = v[j][1] + (*(const f32x4*)(pg + 512 * j + 4) * pfac) * s1;
                u32x4 w; w.x = cvtpk(v[j][0][0], v[j][0][1]); w.y = cvtpk(v[j][0][2], v[j][0][3]); w.z = cvtpk(v[j][1][0], v[j][1][1]); w.w = cvtpk(v[j][1][2], v[j][1][3]);
                *(u32x4*)(XB + (size_t)r * D + 8 * lane + 512 * j) = w;
            }
        }
        norm_row_store(v, gv, sh, sc1, H + (size_t)r * D, lane);
    }
}
__device__ __forceinline__ void final_reduce(const bf16_t* partd, const float* pgate, float pfac, const bf16_t* XB, float* Y, int gw, int ngw, int lane) {
    for (int r = MP + gw; r < M; r += ngw) {
        const bf16_t* pp = partd + (size_t)(r - MP) * D + 8 * lane; const float* pg = pgate + (size_t)row_sidx(r) * NMOD + 8 * lane;
#pragma unroll
        for (int j = 0; j < 2; ++j) {
            const u32x4 b = *(const u32x4*)(XB + (size_t)r * D + 8 * lane + 512 * j);
            u32x4 pb[8];
#pragma unroll
            for (int k = 0; k < 8; ++k) pb[k] = *(const u32x4*)(pp + (size_t)k * MS * D + 512 * j);
            f32x4 s0 = {0.f, 0.f, 0.f, 0.f}, s1 = {0.f, 0.f, 0.f, 0.f};
#pragma unroll
            for (int k = 0; k < 8; ++k) {
                s0 = s0 + (f32x4){__builtin_bit_cast(float, pb[k][0] << 16), __builtin_bit_cast(float, pb[k][0] & 0xffff0000u), __builtin_bit_cast(float, pb[k][1] << 16), __builtin_bit_cast(float, pb[k][1] & 0xffff0000u)};
                s1 = s1 + (f32x4){__builtin_bit_cast(float, pb[k][2] << 16), __builtin_bit_cast(float, pb[k][2] & 0xffff0000u), __builtin_bit_cast(float, pb[k][3] << 16), __builtin_bit_cast(float, pb[k][3] & 0xffff0000u)}; }
            const f32x4 v0 = (f32x4){__builtin_bit_cast(float, b[0] << 16), __builtin_bit_cast(float, b[0] & 0xffff0000u), __builtin_bit_cast(float, b[1] << 16), __builtin_bit_cast(float, b[1] & 0xffff0000u)};
            const f32x4 v1 = (f32x4){__builtin_bit_cast(float, b[2] << 16), __builtin_bit_cast(float, b[2] & 0xffff0000u), __builtin_bit_cast(float, b[3] << 16), __builtin_bit_cast(float, b[3] & 0xffff0000u)};
            float* yo = Y + (size_t)r * D + 8 * lane + 512 * j;
            __builtin_nontemporal_store(v0 + (*(const f32x4*)(pg + 512 * j) * pfac) * s0, (f32x4*)yo); __builtin_nontemporal_store(v1 + (*(const f32x4*)(pg + 512 * j + 4) * pfac) * s1, (f32x4*)(yo + 4));
        }
    }
}

__device__ __forceinline__ int unit_row0(int u) { return u < 1024 ? ((u >> 7) * 2048 + (u & 31) * 64) : MP + ((u - 1024) >> 2) * 64; }
__device__ __forceinline__ int unit_head(int u) { return u < 1024 ? ((u >> 5) & 3) : (u & 3); }
__device__ __forceinline__ void stage_tile_wave(const bf16_t* src, int row0, int pitch, int col0, LAS unsigned char* img, int lane) {
#pragma unroll
    for (int i = 0; i < 16; ++i) { const int n = lane + 64 * i, row = n >> 4, ch = n & 15;
        const u32x4 v = *(const u32x4*)(src + (size_t)(row0 + row) * pitch + col0 + ch * 8);
        *(LAS u32x4*)(img + off_b(row, ch)) = v; }
}
__device__ __forceinline__ void stage_tile_dma(const bf16_t* src, int row0, int pitch, int col0, LAS unsigned char* img, int lane) {
#pragma unroll
    for (int i = 0; i < 16; ++i) { const int n = lane + 64 * i, row = n >> 4, ch = (n & 15) ^ (((row & 3) << 2) | ((row >> 2) & 3));
        __builtin_amdgcn_global_load_lds((const unsigned*)(src + (size_t)(row0 + row) * pitch + col0 + ch * 8), (LAS unsigned*)(img + i * 1024), 16, 0, 0); }
}
#define VM_WAIT0() asm volatile("s_waitcnt vmcnt(0)" ::: "memory")
__device__ __forceinline__ void ret_kv_item(int item, const bf16_t* RK, const bf16_t* RV, unsigned short* KV, LAS unsigned char* img, int lane) {
    const int u = item >> 1, eh = item & 1, r0 = unit_row0(u), h = unit_head(u), hi = lane >> 5, l32 = lane & 31;
    const bf16_t* kt = RK + (size_t)((r0 >> 6) * 4 + h) * 4096;
#pragma unroll
    for (int i = 0; i < 8; ++i) __builtin_amdgcn_global_load_lds((const unsigned*)(kt + i * 512 + lane * 8), (LAS unsigned*)(img + i * 1024), 16, 0, 0);
#pragma unroll
    for (int i = 0; i < 8; ++i) __builtin_amdgcn_global_load_lds((const unsigned*)(RV + (size_t)(r0 + 8 * i + (lane >> 3)) * 512 + h * 128 + eh * 64 + (lane & 7) * 8), (LAS unsigned*)(img + 8192 + i * 1024), 16, 0, 0);
    VM_WAIT0();
    const int blk = (lane >> 4) & 1, q = (lane & 15) >> 2, p = lane & 3;
    f32x16 acc[2][2];
#pragma unroll
    for (int dt = 0; dt < 2; ++dt)
#pragma unroll
        for (int et = 0; et < 2; ++et) acc[dt][et] = (f32x16){};
#pragma unroll
    for (int s = 0; s < 4; ++s) {
        bf16x8 ka[2], vb[2];
#pragma unroll
        for (int dt = 0; dt < 2; ++dt) {
            const int d = 32 * dt + 16 * blk + 4 * p;
            s16x4 t[2];
#pragma unroll
            for (int t2 = 0; t2 < 2; ++t2) { const int j = 16 * s + 8 * hi + 4 * t2 + q;
                t[t2] = ds_tr(img, (unsigned)((((j >> 5) * 4 + (d >> 4)) * 1024) + (((j & 31) + 32 * ((d >> 3) & 1)) * 16) + (d & 7) * 2)); }
            ka[dt] = cat8(t[0], t[1]);
        }
#pragma unroll
        for (int et = 0; et < 2; ++et) {
            s16x4 t[2];
#pragma unroll
            for (int t2 = 0; t2 < 2; ++t2) { const int j = 16 * s + 8 * hi + 4 * t2 + q; t[t2] = ds_tr(img, (unsigned)(8192 + j * 128 + (32 * et + 16 * blk + 4 * p) * 2)); }
            vb[et] = cat8(t[0], t[1]);
        }
#pragma unroll
        for (int dt = 0; dt < 2; ++dt)
#pragma unroll
            for (int et = 0; et < 2; ++et) acc[dt][et] = MFMA32(ka[dt], vb[et], acc[dt][et]);
    }
    unsigned short* o = KV + (size_t)u * 8192 + eh * 64;
#pragma unroll
    for (int dt = 0; dt < 2; ++dt)
#pragma unroll
        for (int et = 0; et < 2; ++et)
#pragma unroll
            for (int r = 0; r < 16; ++r) o[(32 * dt + crow(r, hi)) * 128 + 32 * et + l32] = (unsigned short)f2bf(acc[dt][et][r]);
    LDS_WAIT(); asm volatile("" ::: "memory");
}
__device__ __forceinline__ void ret_out_item(int item, const bf16_t* __restrict__ RQ, const bf16_t* __restrict__ RK, const bf16_t* __restrict__ RV, const bf16_t* __restrict__ SG, const bf16_t* __restrict__ ST, bf16_t* __restrict__ MIX, LAS unsigned char* img, int lane) {
    const int u = item >> 1, it = item & 1, r0 = unit_row0(u), h = unit_head(u), hi = lane >> 5, l32 = lane & 31;
    bf16x8 qf[4], kf[2][4], sa[4][4];
    const bf16_t* qt = RQ + (size_t)((r0 >> 6) * 4 + h) * 4096; const bf16_t* kt = RK + (size_t)((r0 >> 6) * 4 + h) * 4096;
#pragma unroll
    for (int s = 0; s < 4; ++s) qf[s] = *(const bf16x8*)(qt + (it * 4 + s) * 512 + lane * 8);
#pragma unroll
    for (int jt = 0; jt < 2; ++jt)
#pragma unroll
        for (int s = 0; s < 4; ++s) kf[jt][s] = *(const bf16x8*)(kt + ((jt <= it ? jt : 0) * 4 + s) * 512 + lane * 8);
    const bf16_t* stp = ST + (size_t)u * 8192;
#pragma unroll
    for (int et = 0; et < 4; ++et)
#pragma unroll
        for (int s = 0; s < 4; ++s) sa[et][s] = *(const bf16x8*)(stp + (et * 4 + s) * 512 + lane * 8);
    stage_tile_dma(RV, r0, 512, h * 128, img, lane);
    f32x16 o[4];
#pragma unroll
    for (int et = 0; et < 4; ++et) {
        o[et] = (f32x16){};
#pragma unroll
        for (int s = 0; s < 4; ++s) o[et] = MFMA32(sa[et][s], qf[s], o[et]);
    }
    f32x16 p[2];
#pragma unroll
    for (int jt = 0; jt < 2; ++jt) {
        p[jt] = (f32x16){};
        if (jt <= it) {
#pragma unroll
            for (int s = 0; s < 4; ++s) p[jt] = MFMA32(kf[jt][s], qf[s], p[jt]);
            if (jt == it) {
#pragma unroll
                for (int r = 0; r < 16; ++r) if (crow(r, hi) > l32) p[jt][r] = 0.f;
            }
        }
    }
    VM_WAIT0();
#pragma unroll
    for (int jt = 0; jt < 2; ++jt) {
        if (jt <= it) {
#pragma unroll
            for (int s2 = 0; s2 < 2; ++s2) {
                const bf16x8 xb = pack_step(p[jt], s2);
#pragma unroll
                for (int et = 0; et < 4; ++et) {
                    const bf16x8 va = cat8(ds_tr(img, tr_addr(lane, 32 * jt + 16 * s2 + 4 * hi, et)), ds_tr(img, tr_addr(lane, 32 * jt + 16 * s2 + 8 + 4 * hi, et)));
                    o[et] = MFMA32(va, xb, o[et]);
                }
            }
        }
    }
    float ss = 0.f;
#pragma unroll
    for (int et = 0; et < 4; ++et)
#pragma unroll
        for (int r = 0; r < 16; ++r) ss += o[et][r] * o[et][r];
    ss = xor32_sum(ss);
    const float rs = 1.0f / sqrtf(ss * (1.0f / 128.0f) + EPS);
    LDS_WAIT(); asm volatile("" ::: "memory");
#pragma unroll
    for (int et = 0; et < 4; ++et)
#pragma unroll
        for (int rg = 0; rg < 4; ++rg) {
            const int e = 32 * et + 8 * rg + 4 * hi;
            *(LAS unsigned long long*)(img + l32 * 264 + e * 2) = (unsigned long long)cvtpk(o[et][4 * rg] * rs, o[et][4 * rg + 1] * rs) | ((unsigned long long)cvtpk(o[et][4 * rg + 2] * rs, o[et][4 * rg + 3] * rs) << 32);
        }
    LDS_WAIT(); asm volatile("" ::: "memory");
    u32x4 gv[8];
#pragma unroll
    for (int k = 0; k < 8; ++k) gv[k] = *(const u32x4*)(SG + (size_t)(r0 + 32 * it + 4 * k + (lane >> 4)) * 512 + h * 128 + (lane & 15) * 8);
#pragma unroll
    for (int k = 0; k < 8; ++k) {
        const int rr = 4 * k + (lane >> 4), c16 = lane & 15;
        const unsigned long long a0 = *(const LAS unsigned long long*)(img + rr * 264 + c16 * 16), a1 = *(const LAS unsigned long long*)(img + rr * 264 + c16 * 16 + 8);
        const unsigned ov[4] = {(unsigned)a0, (unsigned)(a0 >> 32), (unsigned)a1, (unsigned)(a1 >> 32)};
        u32x4 w;
#pragma unroll
        for (int j = 0; j < 4; ++j) w[j] = cvtpk(__builtin_bit_cast(float, ov[j] << 16) * __builtin_bit_cast(float, gv[k][j] << 16), __builtin_bit_cast(float, ov[j] & 0xffff0000u) * __builtin_bit_cast(float, gv[k][j] & 0xffff0000u));
        *(u32x4*)(MIX + (size_t)(r0 + 32 * it + rr) * D + h * 128 + c16 * 8) = w;
    }
    LDS_WAIT(); asm volatile("" ::: "memory");
}
__device__ __forceinline__ void scan_phase(const unsigned short* __restrict__ KV, bf16_t* __restrict__ SC, const float* __restrict__ state_l, float* __restrict__ sp_l, float* __restrict__ ss_l, int gtid, int gthreads, int wtid) {
    for (int i = wtid; i < 32 * 1024; i += gthreads) {
        const int bh = i >> 10, dg = (i >> 7) & 7, e = i & 127, h = bh & 3;
        const float g64 = exp2f(64.0f * log2f(1.0f - exp2f(-5.0f - (float)h)));
        float S[8];
#pragma unroll
        for (int k = 0; k < 8; ++k) S[k] = 0.f;
        const unsigned short* kvp = KV + (size_t)bh * 32 * 8192 + (size_t)(8 * dg) * 128 + e; bf16_t* scp = SC + (size_t)bh * 32 * 8192 + (size_t)(((e >> 5) * 4 + (dg >> 1)) * 512 + ((e & 31) + 32 * (dg & 1)) * 8);
#pragma unroll 1
        for (int c4 = 0; c4 < 32; c4 += 8) {
            float kv[8][8];
#pragma unroll
            for (int q = 0; q < 8; ++q)
#pragma unroll
                for (int k = 0; k < 8; ++k) kv[q][k] = bf2f(kvp[(size_t)(c4 + q) * 8192 + k * 128]);
#pragma unroll
            for (int q = 0; q < 8; ++q) {
                u32x4 w; w.x = cvtpk(S[0], S[1]); w.y = cvtpk(S[2], S[3]); w.z = cvtpk(S[4], S[5]); w.w = cvtpk(S[6], S[7]);
                *(u32x4*)(scp + (size_t)(c4 + q) * 8192) = w;
#pragma unroll
                for (int k = 0; k < 8; ++k) S[k] = (S[k] + kv[q][k]) * g64;
            }
        }
#pragma unroll
        for (int k = 0; k < 8; ++k) __builtin_nontemporal_store(S[k], sp_l + (size_t)bh * 8192 + (size_t)(8 * dg + k) * 128 + e);
    }
    for (int i = gtid; i < 128 * 1024; i += gthreads) {
        const int bh = i >> 10, dg = (i >> 7) & 7, e = i & 127, h = bh & 3;
        const float g64 = exp2f(64.0f * log2f(1.0f - exp2f(-5.0f - (float)h)));
        const size_t u = 1024 + bh; const size_t eo = (size_t)(8 * dg) * 128 + e;
        float S[8], kv[8];
#pragma unroll
        for (int k = 0; k < 8; ++k) { S[k] = __builtin_nontemporal_load(state_l + (size_t)bh * 8192 + eo + k * 128); kv[k] = bf2f(KV[u * 8192 + eo + k * 128]); }
#pragma unroll
        for (int k = 0; k < 8; ++k) __builtin_nontemporal_store((S[k] + kv[k]) * g64, ss_l + (size_t)bh * 8192 + eo + k * 128);
    }
}

__device__ __forceinline__ void st_sample_init(bf16_t* __restrict__ SC, const float* __restrict__ state_l, int gtid, int gthreads) {
    for (int i = gtid; i < 128 * 1024; i += gthreads) {
        const int bh = i >> 10, dg = (i >> 7) & 7, e = i & 127;
        const size_t eo = (size_t)(8 * dg) * 128 + e;
        float S[8];
#pragma unroll
        for (int k = 0; k < 8; ++k) S[k] = state_l[(size_t)bh * 8192 + eo + k * 128];
        u32x4 w; w.x = cvtpk(S[0], S[1]); w.y = cvtpk(S[2], S[3]); w.z = cvtpk(S[4], S[5]); w.w = cvtpk(S[6], S[7]);
        *(u32x4*)(SC + (size_t)(1024 + bh) * 8192 + (size_t)(((e >> 5) * 4 + (dg >> 1)) * 512 + ((e & 31) + 32 * (dg & 1)) * 8)) = w;
    }
}

#define BAR_LDS() asm volatile("s_waitcnt lgkmcnt(0)\n\ts_barrier" ::: "memory")
__device__ __forceinline__ void glds16(const void* gsrc, unsigned lds_dst) { unsigned keep;
    asm volatile("s_mov_b32 %0, m0\n\ts_mov_b32 m0, %2\n\ts_nop 0\n\tglobal_load_lds_dwordx4 %1, off\n\ts_mov_b32 m0, %0" : "=&s"(keep) : "v"(gsrc), "s"(lds_dst) : "memory"); }
template <int NJT, bool ONLINE>
__device__ __forceinline__ void attn_tile(LAS unsigned char* kimg, LAS unsigned char* vimg, const bf16x8 (&qf)[4], const unsigned (&kaddr)[4], const unsigned (&vaddr)[4][2], f32x16 (&o)[4], float& l_acc, float& m_run, float negm0) {
    f32x16 p[NJT];
#pragma unroll
    for (int jt = 0; jt < NJT; ++jt) {
        f32x16 c;
#pragma unroll
        for (int r = 0; r < 16; ++r) c[r] = ONLINE ? 0.f : negm0;
#pragma unroll
        for (int s = 0; s < 4; ++s) {
            const bf16x8 kf = *(const LAS bf16x8*)(kimg + kaddr[s] + 8192 * jt);
            c = MFMA32(kf, qf[s], c);
        }
        p[jt] = c;
    }
    if (ONLINE) {
        float mx = -1e30f;
#pragma unroll
        for (int jt = 0; jt < NJT; ++jt)
#pragma unroll
            for (int r = 0; r < 16; ++r) mx = fmaxf(mx, p[jt][r]);
        mx = xor32_max(mx);
        const float mn = fmaxf(m_run, mx);
        const float al = __builtin_amdgcn_exp2f(m_run - mn);
        m_run = mn; l_acc *= al;
#pragma unroll
        for (int et = 0; et < 4; ++et)
#pragma unroll
            for (int r = 0; r < 16; ++r) o[et][r] *= al;
#pragma unroll
        for (int jt = 0; jt < NJT; ++jt)
#pragma unroll
            for (int r = 0; r < 16; ++r) p[jt][r] -= mn;
    }
    float ls = 0.f;
#pragma unroll
    for (int jt = 0; jt < NJT; ++jt)
#pragma unroll
        for (int r = 0; r < 16; ++r) { p[jt][r] = __builtin_amdgcn_exp2f(p[jt][r]); ls += p[jt][r]; }
    l_acc += ls;
#pragma unroll
    for (int jt = 0; jt < NJT; ++jt)
#pragma unroll
        for (int s2 = 0; s2 < 2; ++s2) {
            const bf16x8 xb = pack_step(p[jt], s2);
#pragma unroll
            for (int et = 0; et < 4; ++et) {
                const bf16x8 va = cat8(ds_tr(vimg, vaddr[et][0] + 256 * (32 * jt + 16 * s2)), ds_tr(vimg, vaddr[et][1] + 256 * (32 * jt + 16 * s2)));
                o[et] = MFMA32(va, xb, o[et]);
            }
        }
}
__device__ __forceinline__ void diff_finish(const f32x16 (&O)[4], size_t row, int h, const float* gsub, float lscale, bf16_t* MIX, int lane) {
    const int hi = lane >> 5;
    float ss = 0.f;
#pragma unroll
    for (int et = 0; et < 4; ++et)
#pragma unroll
        for (int r = 0; r < 16; ++r) ss += O[et][r] * O[et][r];
    ss = xor32_sum(ss);
    const float rs = lscale / sqrtf(ss * (1.0f / 128.0f) + EPS);
#pragma unroll
    for (int et = 0; et < 4; ++et)
#pragma unroll
        for (int rg = 0; rg < 4; ++rg) {
            const int e = 32 * et + 8 * rg + 4 * hi;
            const f32x4 g = *(const f32x4*)(gsub + e);
            const unsigned long long w = (unsigned long long)cvtpk(O[et][4 * rg] * rs * g[0], O[et][4 * rg + 1] * rs * g[1]) | ((unsigned long long)cvtpk(O[et][4 * rg + 2] * rs * g[2], O[et][4 * rg + 3] * rs * g[3]) << 32);
            *(unsigned long long*)(MIX + row * D + 512 + h * 128 + e) = w;
        }
}
__device__ __forceinline__ void attn_prompt_unit(int b, int h, int qb, const bf16_t* DQ, const bf16_t* DK, const bf16_t* DV, bf16_t* MIX, const float* gsub, float lam, float lscale, float negm0,
                                                 LAS unsigned char* lds, int tid, int wid, int lane) {
    asm volatile("" : "+v"(lane), "+v"(tid));
    const int sub = wid >> 2, iw = wid & 3, hi = lane >> 5, l32 = lane & 31;
    const int rowb = b * 2048, q0 = qb * 128 + 32 * iw;
    const int my_tiles = (q0 >> 6) + 1, NT = 2 * qb + 2;
    bf16x8 qf[4];
#pragma unroll
    for (int s = 0; s < 4; ++s) qf[s] = *(const bf16x8*)(DQ + (size_t)(rowb + q0 + l32) * 512 + h * 128 + sub * 64 + 16 * s + 8 * hi);
    f32x16 o[4];
#pragma unroll
    for (int et = 0; et < 4; ++et) o[et] = (f32x16){};
    float l_acc = 0.f, m_run = 0.f;
    unsigned kaddr[4], vaddr[4][2];
#pragma unroll
    for (int s = 0; s < 4; ++s) kaddr[s] = off_b(l32, sub * 8 + 2 * s + hi);
#pragma unroll
    for (int et = 0; et < 4; ++et) { vaddr[et][0] = tr_addr(lane, 4 * hi, et); vaddr[et][1] = tr_addr(lane, 8 + 4 * hi, et); }
    const int chunk = (lane & 15) ^ ((((lane >> 4) & 3) << 2) | (wid & 3));
    const unsigned goff = (unsigned)((((wid * 4 + (lane >> 4)) * 512) + h * 128 + chunk * 8) * 2);
    const char* kbase = (const char*)(DK + (size_t)rowb * 512); const char* vbase = (const char*)(DV + (size_t)rowb * 512);
#define DMA_TILE(t_, bufoff_) do { const size_t to_ = (size_t)(t_) * 65536; _Pragma("unroll") for (int i_ = 0; i_ < 2; ++i_) { \
        glds16(kbase + to_ + i_ * 32768 + goff, lds0 + (unsigned)((bufoff_) + (i_ * 8 + wid) * 1024)); \
        glds16(vbase + to_ + i_ * 32768 + goff, lds0 + (unsigned)((bufoff_) + 16384 + (i_ * 8 + wid) * 1024)); } } while (0)
    const unsigned lds0 = (unsigned)(size_t)lds;
    asm volatile("" : "+v"(qf[0]), "+v"(qf[1]), "+v"(qf[2]), "+v"(qf[3]));
    DMA_TILE(0, 0); DMA_TILE(1, 32768);
#define ATT_STEP(t_, cur_, nx2_) do { \
        if ((t_) + 1 < NT) asm volatile("s_waitcnt vmcnt(4)" ::: "memory"); else asm volatile("s_waitcnt vmcnt(0)" ::: "memory"); \
        BAR_LDS(); \
        if ((t_) + 2 < NT) DMA_TILE((t_) + 2, nx2_); \
        if ((t_) < my_tiles) attn_tile<2, false>(lds + (cur_), lds + (cur_) + 16384, qf, kaddr, vaddr, o, l_acc, m_run, negm0); } while (0)
#pragma unroll 1
    for (int t = 0; t < NT; t += 3) {
        ATT_STEP(t, 0, 65536);
        if (t + 1 < NT) ATT_STEP(t + 1, 32768, 0);
        if (t + 2 < NT) ATT_STEP(t + 2, 65536, 32768);
    }
#undef ATT_STEP
#undef DMA_TILE
    BAR_LDS();
    l_acc = xor32_sum(l_acc);
    const float il = 1.0f / l_acc;
    LAS float* X = (LAS float*)lds + iw * 4096;
    if (sub == 1) {
        const float f = il * lam;
#pragma unroll
        for (int et = 0; et < 4; ++et)
#pragma unroll
            for (int r = 0; r < 16; ++r) X[(et * 16 + r) * 64 + lane] = o[et][r] * f;
    }
    BAR_LDS();
    if (sub == 0) {
#pragma unroll
        for (int et = 0; et < 4; ++et)
#pragma unroll
            for (int r = 0; r < 16; ++r) o[et][r] = o[et][r] * il - X[(et * 16 + r) * 64 + lane];
        diff_finish(o, (size_t)(rowb + q0 + l32), h, gsub, lscale, MIX, lane);
    }
    BAR_LDS();
}
__device__ __forceinline__ void attn_sample_unit(int bh, const float* ck_l, const float* cv_l, const bf16_t* DQ, const bf16_t* DK, const bf16_t* DV, bf16_t* MIX, const float* gsub, float lam, float lscale,
                                                 LAS unsigned char* lds, int tid, int wid, int lane) {
    asm volatile("" : "+v"(lane), "+v"(tid));
    const int bs = bh >> 2, h = bh & 3;
    const int sub = wid >> 2, it = (wid >> 1) & 1, jh = wid & 1, hi = lane >> 5, l32 = lane & 31;
    const int rowq = MP + bs * 64;
    bf16x8 qf[4];
#pragma unroll
    for (int s = 0; s < 4; ++s) qf[s] = *(const bf16x8*)(DQ + (size_t)(rowq + 32 * it + l32) * 512 + h * 128 + sub * 64 + 16 * s + 8 * hi);
    f32x16 o[4];
#pragma unroll
    for (int et = 0; et < 4; ++et) o[et] = (f32x16){};
    float l_acc = 0.f, m_run = -1e30f;
    unsigned kaddr[4], vaddr[4][2];
#pragma unroll
    for (int s = 0; s < 4; ++s) kaddr[s] = off_b(l32, sub * 8 + 2 * s + hi);
#pragma unroll
    for (int et = 0; et < 4; ++et) { vaddr[et][0] = tr_addr(lane, 4 * hi, et); vaddr[et][1] = tr_addr(lane, 8 + 4 * hi, et); }
    const unsigned jo = 8192u * (unsigned)jh;
    const char* kb = (const char*)(ck_l + (size_t)bs * 4096 * 512 + h * 128);
    const char* vb = (const char*)(cv_l + (size_t)bs * 4096 * 512 + h * 128);
    const unsigned voff = (unsigned)(((tid >> 5) * 512 + (tid & 31) * 4) * 4);
    const unsigned wof = off_b((unsigned)(tid >> 5), (unsigned)((tid & 31) >> 1)) + 8u * (unsigned)(tid & 1);
    f32x4 kx[4], vx[4], ky[4], vy[4];
#define LOAD_TILE(tt_, kr, vr) do { const char* kt_ = kb + (size_t)(tt_) * (64 * 2048); const char* vt_ = vb + (size_t)(tt_) * (64 * 2048); \
        _Pragma("unroll") for (int k_ = 0; k_ < 4; ++k_) { kr[k_] = __builtin_nontemporal_load((const f32x4*)(kt_ + k_ * 32768 + voff)); vr[k_] = __builtin_nontemporal_load((const f32x4*)(vt_ + k_ * 32768 + voff)); } } while (0)
#define WRITE_TILE(bf, kr, vr) do { _Pragma("unroll") for (int k_ = 0; k_ < 4; ++k_) { \
            *(LAS unsigned long long*)(lds + (bf) * 32768 + k_ * 4096 + wof) = (unsigned long long)cvtpk(kr[k_][0], kr[k_][1]) | ((unsigned long long)cvtpk(kr[k_][2], kr[k_][3]) << 32); \
            *(LAS unsigned long long*)(lds + (bf) * 32768 + 16384 + k_ * 4096 + wof) = (unsigned long long)cvtpk(vr[k_][0], vr[k_][1]) | ((unsigned long long)cvtpk(vr[k_][2], vr[k_][3]) << 32); } } while (0)
    LOAD_TILE(0, kx, vx); WRITE_TILE(0, kx, vx); BAR_LDS();
    LOAD_TILE(1, kx, vx);
#pragma unroll 1
    for (int tt = 0; tt < 64; tt += 2) {
        if (tt + 2 < 64) LOAD_TILE(tt + 2, ky, vy);
        attn_tile<1, true>(lds + jo, lds + 16384 + jo, qf, kaddr, vaddr, o, l_acc, m_run, 0.f);
        WRITE_TILE(1, kx, vx); BAR_LDS();
        if (tt + 3 < 64) LOAD_TILE(tt + 3, kx, vx);
        attn_tile<1, true>(lds + 32768 + jo, lds + 32768 + 16384 + jo, qf, kaddr, vaddr, o, l_acc, m_run, 0.f);
        if (tt + 2 < 64) WRITE_TILE(0, ky, vy);
        BAR_LDS();
    }
#undef LOAD_TILE
#undef WRITE_TILE
    {
#pragma unroll
        for (int k_ = 0; k_ < 2; ++k_) { const size_t ro_ = (size_t)(rowq + (tid >> 4) + 32 * k_) * 512 + h * 128 + (tid & 15) * 8; const unsigned of_ = off_b((unsigned)((tid >> 4) + 32 * k_), (unsigned)(tid & 15));
            *(LAS u32x4*)(lds + of_) = *(const u32x4*)(DK + ro_); *(LAS u32x4*)(lds + 16384 + of_) = *(const u32x4*)(DV + ro_); }
        BAR_LDS();
        attn_tile<1, true>(lds + jo, lds + 16384 + jo, qf, kaddr, vaddr, o, l_acc, m_run, 0.f);
        BAR_LDS();
    }
    l_acc = xor32_sum(l_acc);
    LAS float* XP = (LAS float*)lds + (wid >> 1) * (66 * 64);
    if (jh == 1) {
#pragma unroll
        for (int et = 0; et < 4; ++et)
#pragma unroll
            for (int r = 0; r < 16; ++r) XP[(et * 16 + r) * 64 + lane] = o[et][r];
        XP[64 * 64 + lane] = m_run; XP[65 * 64 + lane] = l_acc;
    }
    BAR_LDS();
    if (jh == 0) {
        const float m2 = XP[64 * 64 + lane], l2 = XP[65 * 64 + lane];
        const float mm = fmaxf(m_run, m2), w1 = __builtin_amdgcn_exp2f(m_run - mm), w2 = __builtin_amdgcn_exp2f(m2 - mm);
        const float iL = (sub == 0 ? 1.0f : lam) / (w1 * l_acc + w2 * l2);
        const float a1 = w1 * iL, a2 = w2 * iL;
#pragma unroll
        for (int et = 0; et < 4; ++et)
#pragma unroll
            for (int r = 0; r < 16; ++r) o[et][r] = a1 * o[et][r] + a2 * XP[(et * 16 + r) * 64 + lane];
    }
    BAR_LDS();
    LAS float* XS = (LAS float*)lds + it * 4096;
    if (jh == 0 && sub == 1) {
#pragma unroll
        for (int et = 0; et < 4; ++et)
#pragma unroll
            for (int r = 0; r < 16; ++r) XS[(et * 16 + r) * 64 + lane] = o[et][r];
    }
    BAR_LDS();
    if (jh == 0 && sub == 0) {
#pragma unroll
        for (int et = 0; et < 4; ++et)
#pragma unroll
            for (int r = 0; r < 16; ++r) o[et][r] -= XS[(et * 16 + r) * 64 + lane];
        diff_finish(o, (size_t)(rowq + 32 * it + l32), h, gsub, lscale, MIX, lane);
    }
    BAR_LDS();
}
__device__ __forceinline__ void attn_sample_combine(int item, const float* __restrict__ PART, bf16_t* __restrict__ MIX, const float* gsub, float lam, float lscale, LAS float* xs, int wid, int lane) {
    const int bh = item >> 1, it = item & 1, bs = bh >> 2, h = bh & 3, l32 = lane & 31, hi = lane >> 5;
    const float* P0 = PART + ((size_t)(bh * 2) * 8 + it * 2) * (66 * 64) + lane;
    LAS float* red = xs + 64 * 64;
    float w[8];
#pragma unroll
    for (int sub = 0; sub < 2; ++sub) {
        float m[4], l[4];
#pragma unroll
        for (int k = 0; k < 4; ++k) { const float* q = P0 + (size_t)((k >> 1) * 8 + sub * 4 + (k & 1)) * (66 * 64); m[k] = q[64 * 64]; l[k] = q[65 * 64]; }
        const float mm = fmaxf(fmaxf(m[0], m[1]), fmaxf(m[2], m[3]));
        float L = 0.f;
#pragma unroll
        for (int k = 0; k < 4; ++k) { w[sub * 4 + k] = __builtin_amdgcn_exp2f(m[k] - mm); L += w[sub * 4 + k] * l[k]; }
        const float iL = (sub == 0 ? 1.0f : -lam) / L;
#pragma unroll
        for (int k = 0; k < 4; ++k) w[sub * 4 + k] *= iL;
    }
    float pv[8][8];
#pragma unroll
    for (int k8 = 0; k8 < 8; ++k8)
#pragma unroll
        for (int j = 0; j < 8; ++j) pv[k8][j] = P0[(size_t)((((j & 3) >> 1) * 8) + (j >> 2) * 4 + (j & 1)) * (66 * 64) + (size_t)(8 * wid + k8) * 64];
    float ss = 0.f;
#pragma unroll
    for (int k8 = 0; k8 < 8; ++k8) { float v = 0.f;
#pragma unroll
        for (int j = 0; j < 8; ++j) v += w[j] * pv[k8][j];
        ss += v * v; xs[(8 * wid + k8) * 64 + lane] = v; }
    red[wid * 64 + lane] = ss;
    __syncthreads();
    float st = 0.f;
#pragma unroll
    for (int k = 0; k < 8; ++k) st += red[k * 64 + lane];
    st = xor32_sum(st);
    const float rs = lscale / sqrtf(st * (1.0f / 128.0f) + EPS);
    const size_t row = (size_t)(MP + bs * 64 + 32 * it + l32);
#pragma unroll
    for (int k2 = 0; k2 < 2; ++k2) {
        const int q = 2 * wid + k2, e = 32 * (q >> 2) + 8 * (q & 3) + 4 * hi;
        const f32x4 g = *(const f32x4*)(gsub + e);
        const float v0 = xs[(4 * q) * 64 + lane], v1 = xs[(4 * q + 1) * 64 + lane], v2 = xs[(4 * q + 2) * 64 + lane], v3 = xs[(4 * q + 3) * 64 + lane];
        const unsigned long long wv = (unsigned long long)cvtpk(v0 * rs * g[0], v1 * rs * g[1]) | ((unsigned long long)cvtpk(v2 * rs * g[2], v3 * rs * g[3]) << 32);
        *(unsigned long long*)(MIX + row * D + 512 + h * 128 + e) = wv;
    }
    __syncthreads();
}

struct Args { const float* in[17]; float* out; unsigned char* ws; int ph_lo, ph_hi; };
constexpr int NPL = 12;
constexpr int NPHASES = 2 + 2 * NPL;

__global__ void __launch_bounds__(NTHREADS, 2) fwd_kernel(Args a) {
    extern __shared__ __attribute__((aligned(16))) unsigned char lds_raw[];
    LAS unsigned char* lds = (LAS unsigned char*)lds_raw;
    {
        volatile LAS unsigned* Z = (volatile LAS unsigned*)(lds + RING_BYTES);
        for (int u = threadIdx.x; u < (LDS_BYTES - RING_BYTES) / 4; u += NTHREADS) Z[u] = 0u;
    }
    __syncthreads();
    XcdBarrier bar = xcd_barrier_post((unsigned*)((gu32*)(a.ws + WS_CTL) + CW_BAR), (volatile LAS unsigned*)(lds + MISC_OFF) + 8);
    const int lo = a.ph_lo, hi = a.ph_hi;
    const int wid0 = __builtin_amdgcn_readfirstlane(threadIdx.x >> 6);
#ifndef PHMASK
#define PHMASK 0xFFFF
#endif
#define EN(b) ((PHMASK >> (b)) & 1)
#define IN_PH(k) (lo <= (k) && (k) < hi)
#define SEAM(k) do { if ((k) + 1 < hi) xcd_barrier(bar); } while (0)
#ifndef REPMASK
#define REPMASK 0
#endif
#define REPS(b, cond) for (int rep_ = 0; rep_ < ((((REPMASK) >> (b)) & 1) && (cond) ? 2 : 1); ++rep_)
#define REPBAR() do { if (rep_) xcd_barrier(bar); } while (0)
#define PH_BEGIN() int l = l_, wid = wid0; unsigned z_ = 0u; asm volatile("" : "+s"(l), "+s"(wid), "+s"(z_)); int tid = wid * 64 + (int)__builtin_amdgcn_mbcnt_hi(~0u, __builtin_amdgcn_mbcnt_lo(~0u, z_)); asm volatile("" : "+v"(tid)); \
    const int lane = tid & 63; const int G = gridDim.x, bx = blockIdx.x; \
    const int vcu = (G % 8 == 0) ? (bx % 8) * (G / 8) + bx / 8 : bx; \
    const int gw = vcu * NWAVES + wid, ngw = G * NWAVES, gtid = vcu * NTHREADS + tid, gthreads = G * NTHREADS; \
    unsigned char* ws = a.ws; float* out = a.out; float* X = out; (void)lane; (void)wid; (void)gw; (void)ngw; (void)gtid; (void)gthreads; (void)ws; (void)X; (void)vcu; \
    const float* mod_l = (const float*)(ws + WS_MOD) + (size_t)l * NSEQ * NMOD; (void)mod_l
#define WSP(T, off) ((T*)(ws + (off)))

    if (EN(0) && IN_PH(0)) REPS(0, true) {
        const int l_ = 0; PH_BEGIN();
        for (int item = bx; item < 288; item += G) adaln_item(item, a.in[5], a.in[6], a.in[7], a.in[8], WSP(float, WS_MOD), lds, tid, wid, lane);
        LAS float* scr = (LAS float*)(lds + wid * 16384);
        const float *w_ff_up = a.in[10], *w_ff_down = a.in[11], *w_in = a.in[12], *w_out = a.in[13];
        { const int n2 = 288 > G ? 288 - G : 0;
          if (bx >= n2) for (int itm = (bx - n2) * NWAVES + wid; itm < I_LAYER; itm += (G - n2) * NWAVES) convert_layer_item(0, itm, w_ff_up, w_ff_down, w_in, w_out, ws, scr, lane); }
        SEAM(0);
    }

    for (int l_ = 0; l_ < 2; ++l_) {
        const int pb = 1 + l_ * NPL;
        if (EN(1) && IN_PH(pb + 0)) REPS(1, l_ == 0) { PH_BEGIN();
            const float* mod_prev = (const float*)(ws + WS_MOD);
            norm_phase(l == 0 ? a.in[0] : nullptr, l == 0 ? a.in[1] : nullptr, WSP(bf16_t, WS_XB), a.in[9] + (size_t)(l * 3 + 0) * D, mod_l, 0, WSP(bf16_t, WS_H), gw, ngw, lane, l == 0 ? nullptr : WSP(bf16_t, WS_PARTD), mod_prev + 8 * D, 0.5f); SEAM(pb + 0); }
        if (EN(2) && IN_PH(pb + 1)) REPS(2, true) { PH_BEGIN();
            pg8::Gemm g{WSP(bf16_t, WS_H), WSP(bf16_t, WS_WUP) + (size_t)(l * 2 + 0) * NUP * D, M, NUP, D}; TailOrder S; S.init(M, NUP, G, bx);
            EpiUp E{WSP(bf16_t, WS_ACT)};
            pg8::gemm_phase<EpiUp, TailOrder, true, true>(lds, g, S, E, tid);
            if (l == 0) background_convert(0, 4500, bx - 2 * S.rem, G - 2 * S.rem, wid, a.in[10], a.in[11], a.in[12], a.in[13], ws, lds, lane);
            SEAM(pb + 1);
        }
        if (EN(3) && IN_PH(pb + 2)) REPS(3, l_ == 0) { PH_BEGIN();
            pg8::Gemm g{WSP(bf16_t, WS_ACT), WSP(bf16_t, WS_WDN) + (size_t)(l * 2 + 0) * D * DFF, M, D, DFF}; SplitOrder S; S.init(G, bx, DFF / 64);
            EpiRes E{WSP(bf16_t, WS_XB), X, 0, mod_l + 2 * D, 0.5f, WSP(bf16_t, WS_PARTD)};
            pg8::gemm_phase<EpiRes, SplitOrder, true, true>(lds, g, S, E, tid);
            SEAM(pb + 2);
        }
        if (EN(1) && IN_PH(pb + 3)) REPS(1, l_ == 0) { PH_BEGIN(); norm_phase(nullptr, nullptr, WSP(bf16_t, WS_XB), a.in[9] + (size_t)(l * 3 + 1) * D, mod_l, 1, WSP(bf16_t, WS_H), gw, ngw, lane, WSP(bf16_t, WS_PARTD), mod_l + 2 * D, 0.5f); SEAM(pb + 3); }
        if (EN(4) && IN_PH(pb + 4)) REPS(4, true) { PH_BEGIN();
            pg8::Gemm g{WSP(bf16_t, WS_H), WSP(bf16_t, WS_WIN) + (size_t)l * DIN * D, M, DIN, D}; TailOrder S; S.init(M, DIN, G, bx);
            EpiIn E{WSP(bf16_t, WS_RQ), WSP(bf16_t, WS_RK), WSP(bf16_t, WS_RV), WSP(bf16_t, WS_SG), WSP(bf16_t, WS_DQ), WSP(bf16_t, WS_DK), WSP(bf16_t, WS_DV),
                    out + O_KP + (size_t)l * MP * 512, out + O_KS + (size_t)l * MS * 512, out + O_VP + (size_t)l * MP * 512, out + O_VS + (size_t)l * MS * 512, a.in[14] + (size_t)l * 128};
            pg8::gemm_phase<EpiIn, TailOrder, true, true>(lds, g, S, E, tid);
            if (l == 0) background_convert(4500, 5996, bx - 2 * S.rem, G - 2 * S.rem, wid, a.in[10], a.in[11], a.in[12], a.in[13], ws, lds, lane);
            SEAM(pb + 4);
        }
#define LAMBDA_SETUP() float lam, negm0; const float lam_init = l == 0 ? 0.2f : 0.35550906759096926f; { \
            const float* wl = a.in[15] + (size_t)l * 256; const float* gq_ = a.in[14] + (size_t)l * 128; \
            const float s1 = wave_sum(wl[lane] * wl[64 + lane]), s2 = wave_sum(wl[128 + lane] * wl[192 + lane]); \
            lam = __expf(s1) - __expf(s2) + lam_init; \
            const float gq = wave_max(fabsf(gq_[lane])), gk = wave_max(fabsf(gq_[64 + lane])); \
            negm0 = -(C2 * 64.0f * gq * gk * 1.02f); } \
            const float lscale = 1.0f - lam_init; const float* gsub_l = a.in[16] + (size_t)l * 128; (void)negm0; (void)lscale; (void)gsub_l
        if (IN_PH(pb + 5)) {
            { PH_BEGIN();
                const int role = (bx >> 3) & 1, r = (bx >> 4) * 8 + (bx & 7), nr = G >> 1;
                if (role == 0) {
                    LAMBDA_SETUP();
#pragma unroll 1
                    for (int unit = r; unit < 128; unit += nr)
                        attn_sample_unit(unit, a.in[2] + (size_t)l * 32 * 4096 * 512, a.in[3] + (size_t)l * 32 * 4096 * 512, WSP(bf16_t, WS_DQ), WSP(bf16_t, WS_DK), WSP(bf16_t, WS_DV), WSP(bf16_t, WS_MIX), gsub_l, lam, lscale, lds, tid, wid, lane);
                } else {
                    LAMBDA_SETUP();
#pragma unroll 1
                    for (int q = r; q < 256; q += nr) {
                        const int j = q >> 3, bh = 4 * (q & 7) + (j >> 3), s = j & 7;
#pragma unroll 1
                        for (int k = 0; k < 2; ++k)
                            attn_prompt_unit(bh >> 2, bh & 3, k ? 15 - s : s, WSP(bf16_t, WS_DQ), WSP(bf16_t, WS_DK), WSP(bf16_t, WS_DV), WSP(bf16_t, WS_MIX), gsub_l, lam, lscale, negm0, lds, tid, wid, lane);
                    }
                }
            }
            __syncthreads();
            if (EN(7)) REPS(9, true) { PH_BEGIN();
                st_sample_init(WSP(bf16_t, WS_SC), a.in[4] + (size_t)l * 128 * 8192, gtid, gthreads);
                for (int item = gw; item < 2304; item += ngw) ret_kv_item(item, WSP(bf16_t, WS_RK), WSP(bf16_t, WS_RV), WSP(unsigned short, WS_KV), lds + wid * 16384, lane);
            }
            SEAM(pb + 5);
        }
        if (IN_PH(pb + 6)) REPS(6, true) { PH_BEGIN(); LAMBDA_SETUP();
            if (EN(8)) scan_phase(WSP(unsigned short, WS_KV), WSP(bf16_t, WS_SC), a.in[4] + (size_t)l * 128 * 8192, out + O_SP + (size_t)l * 32 * 8192, out + O_SS + (size_t)l * 128 * 8192, gtid, gthreads, (wid * G + vcu) * 64 + lane);
            if (EN(9) && wid == 2) for (int item = 2048 + vcu; item < 2304; item += G) ret_out_item(item, WSP(bf16_t, WS_RQ), WSP(bf16_t, WS_RK), WSP(bf16_t, WS_RV), WSP(bf16_t, WS_SG), WSP(bf16_t, WS_SC), WSP(bf16_t, WS_MIX), lds + wid * 16384, lane);
            SEAM(pb + 6);
        }
        if (EN(9) && IN_PH(pb + 7)) REPS(7, true) { PH_BEGIN();
            for (int item = gw; item < 2048; item += ngw) ret_out_item(item, WSP(bf16_t, WS_RQ), WSP(bf16_t, WS_RK), WSP(bf16_t, WS_RV), WSP(bf16_t, WS_SG), WSP(bf16_t, WS_SC), WSP(bf16_t, WS_MIX), lds + wid * 16384, lane);
            SEAM(pb + 7);
        }
        if (EN(3) && IN_PH(pb + 8)) { PH_BEGIN();
            pg8::Gemm g{WSP(bf16_t, WS_MIX), WSP(bf16_t, WS_WOUT) + (size_t)l * D * D, M, D, D}; SplitOrder S; S.init(G, bx, D / 64);
            EpiRes E{WSP(bf16_t, WS_XB), X, 0, mod_l + 5 * D, 1.0f, WSP(bf16_t, WS_PARTD)};
            pg8::gemm_phase<EpiRes, SplitOrder, true, true>(lds, g, S, E, tid);
            SEAM(pb + 8);
        }
        if (EN(1) && IN_PH(pb + 9)) { PH_BEGIN(); norm_phase(nullptr, nullptr, WSP(bf16_t, WS_XB), a.in[9] + (size_t)(l * 3 + 2) * D, mod_l, 2, WSP(bf16_t, WS_H), gw, ngw, lane, WSP(bf16_t, WS_PARTD), mod_l + 5 * D, 1.0f); SEAM(pb + 9); }
        if (EN(2) && IN_PH(pb + 10)) REPS(2, true) { PH_BEGIN();
            pg8::Gemm g{WSP(bf16_t, WS_H), WSP(bf16_t, WS_WUP) + (size_t)(l * 2 + 1) * NUP * D, M, NUP, D}; TailOrder S; S.init(M, NUP, G, bx);
            EpiUp E{WSP(bf16_t, WS_ACT)};
            pg8::gemm_phase<EpiUp, TailOrder, true, true>(lds, g, S, E, tid);
            if (l == 0) background_convert(5996, I_LAYER, bx - 2 * S.rem, G - 2 * S.rem, wid, a.in[10], a.in[11], a.in[12], a.in[13], ws, lds, lane);
            SEAM(pb + 10);
        }
        if (EN(3) && IN_PH(pb + 11)) { PH_BEGIN();
            pg8::Gemm g{WSP(bf16_t, WS_ACT), WSP(bf16_t, WS_WDN) + (size_t)(l * 2 + 1) * D * DFF, M, D, DFF}; SplitOrder S; S.init(G, bx, DFF / 64);
            EpiRes E{WSP(bf16_t, WS_XB), X, l, mod_l + 8 * D, 0.5f, WSP(bf16_t, WS_PARTD)};
            pg8::gemm_phase<EpiRes, SplitOrder, true, true>(lds, g, S, E, tid);
            SEAM(pb + 11);
        }
    }
    if (IN_PH(1 + 2 * NPL)) { const int l_ = 1; PH_BEGIN();
        final_reduce(WSP(bf16_t, WS_PARTD), mod_l + 8 * D, 0.5f, WSP(bf16_t, WS_XB), X, gw, ngw, lane);
    }
#undef IN_PH
#undef SEAM
}

#ifndef MK_N_LAUNCHES
#define MK_N_LAUNCHES 1
#endif
extern "C" void kernel_launch(void* const* d_in, const int* in_sizes, int n_in, void* d_out, int out_size, void* d_ws, size_t ws_size, hipStream_t stream) {
    static int grid = 0;
    if (grid == 0) {
        if (n_in != 17 || ws_size < WS_END) { fprintf(stderr, "kernel_launch: unexpected n_in %d / ws %zu\n", n_in, ws_size); grid = -1; return; }
        int dev = 0, cus = 0, per_cu = 0;
        if (hipGetDevice(&dev) != hipSuccess || hipDeviceGetAttribute(&cus, hipDeviceAttributeMultiprocessorCount, dev) != hipSuccess) { grid = -1; return; }
        if (hipFuncSetAttribute((const void*)fwd_kernel, hipFuncAttributeMaxDynamicSharedMemorySize, LDS_BYTES) != hipSuccess) { fprintf(stderr, "kernel_launch: hipFuncSetAttribute failed\n"); grid = -1; return; }
        if (hipOccupancyMaxActiveBlocksPerMultiprocessor(&per_cu, (const void*)fwd_kernel, NTHREADS, LDS_BYTES) != hipSuccess || per_cu < 1)
            fprintf(stderr, "kernel_launch: occupancy query reports %d blocks per CU\n", per_cu);
        (void)hipGetLastError();
        grid = cus < 256 ? cus : 256;
    }
    if (grid < 0) return;
    if (hipMemsetAsync((char*)d_ws + WS_CTL, 0, CTL_ZERO_BYTES, stream) != hipSuccess) return;
    Args a{};
    for (int i = 0; i < 17; ++i) a.in[i] = (const float*)d_in[i];
    a.out = (float*)d_out; a.ws = (unsigned char*)d_ws;
    if (MK_N_LAUNCHES == 1) {
        a.ph_lo = 0; a.ph_hi = NPHASES;
        hipLaunchKernelGGL(fwd_kernel, dim3(grid), dim3(NTHREADS), LDS_BYTES, stream, a);
    } else {
        for (int p = 0; p < NPHASES; ++p) { a.ph_lo = p; a.ph_hi = p + 1; hipLaunchKernelGGL(fwd_kernel, dim3(grid), dim3(NTHREADS), LDS_BYTES, stream, a); }
    }
}
```

```cpp
#include <hip/hip_runtime.h>
#include <cstdio>
#include <cstdint>
namespace pg8 {
#define PG8_LAS __attribute__((address_space(3)))
typedef unsigned short bf16_t;
typedef short bf16x8 __attribute__((ext_vector_type(8)));
typedef float f32x4 __attribute__((ext_vector_type(4)));
typedef unsigned u32x4 __attribute__((ext_vector_type(4)));
constexpr int BM = 256, BK = 64, HALF = 128, HTB = HALF * BK * 2  , STAGE_BYTES = 8 * HTB, NXCD = 8, WGM = 4;

__host__ __device__ __forceinline__ int lds_byte(int r, int c) { const int st = (r >> 4) * 2 + (c >> 5), rr = r & 15, cc = c & 31, ob = rr * 64 + cc * 2; return st * 1024 + (ob ^ (((ob >> 9) & 1) << 5)); }
__host__ __device__ __forceinline__ void stage_rc(int b, int& R, int& C) { const int st = b / 1024, sb = b % 1024, swz = sb ^ (((sb >> 9) & 1) << 5); R = (st >> 1) * 16 + swz / 64; C = (st & 1) * 32 + (swz % 64) / 2; }
__host__ __device__ __forceinline__ int perm32(int rho) { const int n = rho >> 4, i = rho & 15; return 8 * (i >> 2) + 4 * n + (i & 3); }

struct Unit { int pm, pn, kt0, nkt, aux, half; };
struct Gemm { const bf16_t* A; const bf16_t* Bt; int M, N, K; };

struct StaticOrder {
    int nM, nN, nwg, G, c;
    __host__ __device__ __forceinline__ void init(int M, int N, int G_, int c_) { nM = M / BM; nN = N / BM; nwg = nM * nN; G = G_; c = c_; }
    __host__ __device__ __forceinline__ bool next(int i, Unit& u) const { return at((long)i * G + c, u); }
    __host__ __device__ __forceinline__ bool at(long L, Unit& u) const {
        if (L >= nwg) return false;
        int wgid = (int)L; { const int q = nwg / NXCD, r = nwg % NXCD, xcd = wgid % NXCD, off = wgid / NXCD; wgid = (xcd < r ? xcd * (q + 1) : r * (q + 1) + (xcd - r) * q) + off; }
        const int nig = WGM * nN, gid = wgid / nig, fm = gid * WGM, gsz = (nM - fm) < WGM ? (nM - fm) : WGM;
        u.pm = fm + ((wgid % nig) % gsz); u.pn = (wgid % nig) / gsz; u.kt0 = 0; u.nkt = 0; u.aux = 0; u.half = 0; return true;
    }
    __device__ __forceinline__ void a_ready(const Unit&) const {}
    __device__ __forceinline__ void done(const Unit&) const {}
};

__device__ __forceinline__ unsigned cvt_pk_bf16(float lo, float hi) { unsigned r; asm volatile("v_cvt_pk_bf16_f32 %0, %1, %2" : "=v"(r) : "v"(lo), "v"(hi)); return r; }
typedef float f32x2 __attribute__((ext_vector_type(2)));
template <class Epi, class Sched, bool ALIGN_EPI = false, bool SP2 = false>
__device__ __forceinline__ void gemm_phase(PG8_LAS unsigned char* lds, const Gemm g, const Sched& S, const Epi& E, int tid) {
    asm volatile("" : "+v"(tid));
    const int wid = __builtin_amdgcn_readfirstlane(tid >> 6), lane = tid & 63, wr = wid >> 2, wc = wid & 3, fr = lane & 15, fq = lane >> 4;
    const int K = g.K, ntK = K / BK;
    unsigned voffA[2], voffB[2];
#pragma unroll
    for (int i = 0; i < 2; ++i) { int R, C; stage_rc(tid * 16 + i * 8192, R, C); const int Rb = Epi::PERM ? ((R & ~31) + perm32(R & 31)) : R;
        voffA[i] = (unsigned)(R * K + C) * 2u; voffB[i] = (unsigned)(Rb * K + C) * 2u; }
    const size_t kstep = (size_t)(BK * 2);
    const size_t hstep = (size_t)HALF * K * 2;
    const size_t tstep = 2 * hstep;
    const unsigned ldsw = (unsigned)wid * 1024u;
    const int aoff = lds_byte(wr * 64 + fr, fq * 8), boff = lds_byte(wc * 32 + fr, fq * 8);
#define PG8_SA(b, h) (((b) * 2 + (h)) * HTB)
#define PG8_SB(b, h) ((4 + (b) * 2 + (h)) * HTB)
#define PG8_STAGE(bufoff, gbase, voff) do { _Pragma("unroll") for (int _i = 0; _i < 2; ++_i) \
        __builtin_amdgcn_global_load_lds((const unsigned*)((const char*)(gbase) + (voff)[_i]), (PG8_LAS unsigned*)(lds + (bufoff) + ldsw + _i * 8192), 16, 0, 0); } while (0)
#define PG8_LDA(dst, b, h) do { _Pragma("unroll") for (int m = 0; m < 4; ++m) _Pragma("unroll") for (int k = 0; k < 2; ++k) dst[m][k] = *(const PG8_LAS bf16x8*)(lds + PG8_SA(b, h) + aoff + m * 2048 + k * 1024); } while (0)
#define PG8_LDB(dst, b, h) do { _Pragma("unroll") for (int n = 0; n < 2; ++n) _Pragma("unroll") for (int k = 0; k < 2; ++k) dst[n][k] = *(const PG8_LAS bf16x8*)(lds + PG8_SB(b, h) + boff + n * 2048 + k * 1024); } while (0)
#define PG8_MMA(ai, bj, At, Bt) do { __builtin_amdgcn_s_setprio(1); _Pragma("unroll") for (int m = 0; m < 4; ++m) _Pragma("unroll") for (int n = 0; n < 2; ++n) _Pragma("unroll") for (int k = 0; k < 2; ++k) \
        acc[ai][bj][m][n] = __builtin_amdgcn_mfma_f32_16x16x32_bf16(Bt[n][k], At[m][k], acc[ai][bj][m][n], 0, 0, 0); __builtin_amdgcn_s_setprio(0); } while (0)
#define PG8_WAIT_V(n) asm volatile("s_waitcnt vmcnt(" #n ")" ::: "memory")
#define PG8_WAIT_L(n) asm volatile("s_waitcnt lgkmcnt(" #n ")" ::: "memory")
#define PG8_BAR __builtin_amdgcn_s_barrier()
#define PG8_SCHED __builtin_amdgcn_sched_barrier(0)
    Unit cur, nxt; int ui = 0;
    if (!S.next(0, cur)) return;
    f32x4 acc[2][2][4][2];
#pragma unroll
    for (int a = 0; a < 2; ++a)
#pragma unroll
        for (int b = 0; b < 2; ++b)
#pragma unroll
            for (int m = 0; m < 4; ++m)
#pragma unroll
                for (int n = 0; n < 2; ++n) acc[a][b][m][n] = (f32x4){0.f, 0.f, 0.f, 0.f};
    bf16x8 At[4][2], B0[2][2], B1[2][2];
    const char* cA = (const char*)g.A + (size_t)cur.pm * tstep + (size_t)cur.kt0 * kstep + (cur.half == 2 ? hstep : 0); const char* cB = (const char*)g.Bt + (size_t)cur.pn * tstep + (size_t)cur.kt0 * kstep;
    S.a_ready(cur);
    if constexpr (SP2) {
        PG8_STAGE(PG8_SB(0, 0), cB, voffB); PG8_STAGE(PG8_SB(0, 1), cB + hstep, voffB); PG8_STAGE(PG8_SA(0, 0), cA, voffA); PG8_STAGE(PG8_SA(0, 1), cA + hstep, voffA);
        if (wr == 1) PG8_BAR;
        PG8_WAIT_V(2); PG8_BAR;
        PG8_STAGE(PG8_SB(1, 0), cB + kstep, voffB); PG8_STAGE(PG8_SA(1, 0), cA + kstep, voffA); PG8_STAGE(PG8_SB(1, 1), cB + hstep + kstep, voffB);
        PG8_WAIT_V(6); PG8_BAR;
    } else {
        PG8_STAGE(PG8_SB(0, 0), cB, voffB); PG8_STAGE(PG8_SA(0, 0), cA, voffA); PG8_STAGE(PG8_SB(0, 1), cB + hstep, voffB); PG8_STAGE(PG8_SA(0, 1), cA + hstep, voffA);
        if (wr == 1) PG8_BAR;
        PG8_WAIT_V(4); PG8_BAR;
        PG8_STAGE(PG8_SB(1, 0), cB + kstep, voffB); PG8_STAGE(PG8_SA(1, 0), cA + kstep, voffA); PG8_STAGE(PG8_SB(1, 1), cB + hstep + kstep, voffB);
        PG8_WAIT_V(6); PG8_BAR;
    }
    for (;;) {
        const bool has_next = S.next(ui + 1, nxt);
        const char* nA = has_next ? (const char*)g.A + (size_t)nxt.pm * tstep + (size_t)nxt.kt0 * kstep + (nxt.half == 2 ? hstep : 0) : cA; const char* nB = has_next ? (const char*)g.Bt + (size_t)nxt.pn * tstep + (size_t)nxt.kt0 * kstep : cB;
        const int nt = cur.nkt ? cur.nkt : ntK; const bool full = cur.half == 0;
        for (int t = 0; t < nt; t += 2) {
            const bool last = (t == nt - 2);
            const char* a1 = cA + (size_t)(t + 1) * kstep;
            const char* a2 = last ? nA : cA + (size_t)(t + 2) * kstep; const char* b2 = last ? nB : cB + (size_t)(t + 2) * kstep;
            const char* a3 = a2 + kstep; const char* b3 = b2 + kstep;
            if (last && has_next) S.a_ready(nxt);
            if constexpr (SP2) {
            PG8_LDB(B0, 0, 0); PG8_LDB(B1, 0, 1); PG8_SCHED; PG8_LDA(At, 0, 0); PG8_STAGE(PG8_SA(1, 1), a1 + hstep, voffA);
            PG8_WAIT_V(8); PG8_WAIT_L(0); PG8_BAR; PG8_MMA(0, 0, At, B0); PG8_MMA(0, 1, At, B1); PG8_BAR; PG8_SCHED;
            if (full) PG8_LDA(At, 0, 1); PG8_STAGE(PG8_SB(0, 0), b2, voffB); PG8_STAGE(PG8_SB(0, 1), b2 + hstep, voffB); PG8_STAGE(PG8_SA(0, 0), a2, voffA);
            PG8_WAIT_V(8); PG8_WAIT_L(0); PG8_BAR; if (full) { PG8_MMA(1, 0, At, B0); PG8_MMA(1, 1, At, B1); } PG8_BAR; PG8_SCHED;
            PG8_LDB(B0, 1, 0); PG8_LDB(B1, 1, 1); PG8_SCHED; PG8_LDA(At, 1, 0); PG8_STAGE(PG8_SA(0, 1), a2 + hstep, voffA);
            PG8_WAIT_V(8); PG8_WAIT_L(0); PG8_BAR; PG8_MMA(0, 0, At, B0); PG8_MMA(0, 1, At, B1); PG8_BAR; PG8_SCHED;
            if (full) PG8_LDA(At, 1, 1); PG8_STAGE(PG8_SB(1, 0), b3, voffB); PG8_STAGE(PG8_SB(1, 1), b3 + hstep, voffB); PG8_STAGE(PG8_SA(1, 0), a3, voffA);
            PG8_WAIT_V(8); PG8_WAIT_L(0); PG8_BAR; if (full) { PG8_MMA(1, 0, At, B0); PG8_MMA(1, 1, At, B1); } PG8_BAR; PG8_SCHED;
            } else {
            PG8_LDB(B0, 0, 0); PG8_SCHED; PG8_LDA(At, 0, 0); PG8_STAGE(PG8_SA(1, 1), a1 + hstep, voffA);
            PG8_WAIT_L(8); PG8_BAR; PG8_WAIT_L(0); PG8_MMA(0, 0, At, B0); PG8_BAR; PG8_SCHED;
            PG8_LDB(B1, 0, 1); PG8_STAGE(PG8_SB(0, 0), b2, voffB);
            PG8_BAR; PG8_WAIT_L(0); PG8_MMA(0, 1, At, B1); PG8_BAR;
            PG8_LDA(At, 0, 1); PG8_STAGE(PG8_SA(0, 0), a2, voffA);
            PG8_BAR; PG8_WAIT_L(0); PG8_MMA(1, 0, At, B0); PG8_BAR; PG8_SCHED;
            PG8_STAGE(PG8_SB(0, 1), b2 + hstep, voffB);
            PG8_WAIT_V(6); PG8_BAR; PG8_MMA(1, 1, At, B1); PG8_BAR;
            PG8_LDB(B0, 1, 0); PG8_SCHED; PG8_LDA(At, 1, 0); PG8_STAGE(PG8_SA(0, 1), a2 + hstep, voffA);
            PG8_WAIT_L(8); PG8_BAR; PG8_WAIT_L(0); PG8_MMA(0, 0, At, B0); PG8_BAR; PG8_SCHED;
            PG8_LDB(B1, 1, 1); PG8_STAGE(PG8_SB(1, 0), b3, voffB);
            PG8_BAR; PG8_WAIT_L(0); PG8_MMA(0, 1, At, B1); PG8_BAR;
            PG8_LDA(At, 1, 1); PG8_STAGE(PG8_SA(1, 0), a3, voffA);
            PG8_BAR; PG8_WAIT_L(0); PG8_MMA(1, 0, At, B0); PG8_BAR; PG8_SCHED;
            PG8_STAGE(PG8_SB(1, 1), b3 + hstep, voffB);
            PG8_WAIT_V(6); PG8_BAR; PG8_MMA(1, 1, At, B1); PG8_BAR;
            }
        }
        if constexpr (ALIGN_EPI) { if (wr == 0) PG8_BAR; }
        if constexpr (!Epi::AFTER_DRAIN) { E(acc, cur, wr, wc, fr, fq); S.done(cur); }
        if (!has_next) break;
#pragma unroll
        for (int a = 0; a < 2; ++a)
#pragma unroll
            for (int b = 0; b < 2; ++b)
#pragma unroll
                for (int m = 0; m < 4; ++m)
#pragma unroll
                    for (int n = 0; n < 2; ++n) acc[a][b][m][n] = (f32x4){0.f, 0.f, 0.f, 0.f};
        cur = nxt; cA = nA; cB = nB; ++ui;
        if constexpr (ALIGN_EPI) { if (wr == 1) PG8_BAR; }
    }
    PG8_WAIT_V(0);
    if constexpr (!ALIGN_EPI) { if (wr == 0) PG8_BAR; }
    PG8_BAR;
    if constexpr (Epi::AFTER_DRAIN) { E.fused(acc, cur, wr, wc, fr, fq, lds, wid, lane); S.done(cur); }
#undef PG8_SA
#undef PG8_SB
#undef PG8_STAGE
#undef PG8_LDA
#undef PG8_LDB
#undef PG8_MMA
#undef PG8_WAIT_V
#undef PG8_WAIT_L
#undef PG8_BAR
#undef PG8_SCHED
}
}
#define GAS __attribute__((address_space(1)))
#define LAS __attribute__((address_space(3)))
typedef unsigned short bf16;
typedef unsigned v4u __attribute__((ext_vector_type(4)));
typedef float f32x4 __attribute__((ext_vector_type(4)));
typedef short bf16x8 __attribute__((ext_vector_type(8)));
typedef GAS unsigned gu32;
typedef GAS unsigned long long gu64;
#define RLX_AGENT __ATOMIC_RELAXED, __HIP_MEMORY_SCOPE_AGENT
#define LDS_WAIT() asm volatile("s_waitcnt lgkmcnt(0)" ::: "memory")
#define VM_WAIT() asm volatile("s_waitcnt vmcnt(0)" ::: "memory")
__device__ __forceinline__ unsigned long long rt() { return __builtin_amdgcn_s_memrealtime(); }
__device__ __forceinline__ unsigned f2bf(float f) { unsigned u = __builtin_bit_cast(unsigned, f); return (u + 0x7fffu + ((u >> 16) & 1u)) >> 16; }
__device__ __forceinline__ unsigned pk2(float lo, float hi) { return f2bf(lo) | (f2bf(hi) << 16); }

#define XB_TMO      128
#define XB_XCNT(j)  (256  + 64 * (j))
#define XB_XSUB(j)  (1280 + 64 * (j))
#define XB_XGEN(j)  (2304 + 64 * (j))
#define XB_TOP      3328
#define XB_TOPGEN   3392
#define XCD_BAR_WORDS 3456
#define XB_SPIN_CAP (1u << 18)

__device__ __forceinline__ unsigned xb_ld(unsigned* p)              { return __hip_atomic_load(p, __ATOMIC_RELAXED, __HIP_MEMORY_SCOPE_AGENT); }
__device__ __forceinline__ unsigned xb_add(unsigned* p, unsigned v) { return __hip_atomic_fetch_add(p, v, __ATOMIC_RELAXED, __HIP_MEMORY_SCOPE_AGENT); }
__device__ __forceinline__ unsigned xb_xcc_id() { return (unsigned)__builtin_amdgcn_s_getreg((3 << 11) | 20) & 0xFu; }
#define XB_SPIN(cond, bar) do { unsigned _sp = 0; while (cond) { __builtin_amdgcn_s_sleep(0); \
    if ((++_sp & 255u) == 0u) { if (xb_ld(&(bar)[XB_TMO])) break; if (_sp > XB_SPIN_CAP) { atomicAdd(&(bar)[XB_TMO], 1u); break; } } } } while (0)

struct XcdBarrier {
    unsigned* bar; unsigned x;
    volatile LAS unsigned* st;
};

__device__ __forceinline__ XcdBarrier xcd_barrier_post(unsigned* bar, volatile LAS unsigned* st) {
    XcdBarrier b; b.bar = bar; b.x = xb_xcc_id(); b.st = st;
    if (threadIdx.x == 0) (void)xb_add(&bar[XB_XCNT(b.x)], 1u);
    return b;
}
__device__ __forceinline__ void xcd_barrier_complete(unsigned* bar, unsigned x, unsigned& nloc, unsigned& nx) {
    const unsigned G = gridDim.x * gridDim.y * gridDim.z;
    unsigned sum, cnt, mine, sp = 0u;
    for (;;) {
        sum = 0u; cnt = 0u; mine = 0u;
#pragma unroll
        for (unsigned j = 0; j < 16; ++j) { const unsigned c = xb_ld(&bar[XB_XCNT(j)]); sum += c; cnt += (c > 0u) ? 1u : 0u; mine = (j == x) ? c : mine; }
        if (sum == G) break;
        __builtin_amdgcn_s_sleep(1);
        if ((++sp & 255u) == 0u) { if (xb_ld(&bar[XB_TMO])) break; if (sp > XB_SPIN_CAP) { atomicAdd(&bar[XB_TMO], 1u); break; } }
    }
    nloc = mine > 0u ? mine : 1u; nx = cnt > 0u ? cnt : 1u;
}

__device__ __forceinline__ void xcd_barrier(const XcdBarrier& b) {
    asm volatile("s_waitcnt vmcnt(0)" ::: "memory");
    __syncthreads();
    if (threadIdx.x == 0) {
        unsigned* bar = b.bar;
        __builtin_amdgcn_s_waitcnt(0);
        unsigned nloc = b.st[0], nx = b.st[1];
        if (nloc == 0u) { xcd_barrier_complete(bar, b.x, nloc, nx); b.st[0] = nloc; b.st[1] = nx; }
        const unsigned old = xb_add(&bar[XB_XSUB(b.x)], 1u);
        const unsigned gen = old / nloc;
        if (old + 1u == (gen + 1u) * nloc) {
            __builtin_amdgcn_fence(__ATOMIC_RELEASE, "agent");
            asm volatile("s_waitcnt vmcnt(0)" ::: "memory");
            const unsigned og = xb_add(&bar[XB_TOP], 1u);
            const unsigned tg = og / nx;
            if (og + 1u == (tg + 1u) * nx) xb_add(&bar[XB_TOPGEN], 1u);
            else XB_SPIN(xb_ld(&bar[XB_TOPGEN]) == tg, bar);
            __builtin_amdgcn_fence(__ATOMIC_ACQUIRE, "agent");
            xb_add(&bar[XB_XGEN(b.x)], 1u);
            asm volatile("s_waitcnt vmcnt(0)" ::: "memory");
        } else {
            XB_SPIN(xb_ld(&bar[XB_XGEN(b.x)]) == gen, bar);
            __builtin_amdgcn_fence(__ATOMIC_ACQUIRE, "agent");
            asm volatile("s_waitcnt vmcnt(0)" ::: "memory");
        }
    }
    __syncthreads();
}

constexpr int D = 1024, MP = 16384, MS = 2048, M = MP + MS, DFF = 2816, NUP = 2 * DFF, DIN = 3072, NSEQ = 40, NMOD = 9216;
constexpr int NWAVES = 8, NTHREADS = 512;
constexpr float EPS = 1e-6f;
constexpr float C2 = 0.125f * 1.4426950408889634f;
constexpr size_t O_YP = 0, O_YS = 16777216, O_KP = 18874368, O_VP = 35651584, O_SP = 52428800, O_KS = 52953088, O_VS = 55050240, O_SS = 57147392;
constexpr size_t MiB = 1u << 20;
constexpr size_t WS_CTL = 0, CTL_ZERO_BYTES = 64 * 1024;
constexpr size_t WS_MOD = 1 * MiB;
constexpr size_t WS_TRIG = 4 * MiB;
constexpr size_t WS_WUP = 8 * MiB;
constexpr size_t WS_WDN = 52 * MiB;
constexpr size_t WS_WIN = 74 * MiB;
constexpr size_t WS_WOUT = 86 * MiB;
constexpr size_t WS_H = 90 * MiB;
constexpr size_t WS_ACT = 126 * MiB;
constexpr size_t WS_MIX = 225 * MiB;
constexpr size_t WS_RQ = 261 * MiB;
constexpr size_t WS_RK = 270 * MiB;
constexpr size_t WS_RV = 279 * MiB;
constexpr size_t WS_SG = 297 * MiB;
constexpr size_t WS_DQ = 315 * MiB;
constexpr size_t WS_DK = 333 * MiB;
constexpr size_t WS_DV = 351 * MiB;
constexpr size_t WS_KV = 369 * MiB;
constexpr size_t WS_SC = 405 * MiB;
constexpr size_t WS_PART = 423 * MiB;
constexpr size_t WS_PARTD = 460 * MiB;
constexpr size_t WS_XB = 492 * MiB;
constexpr size_t WS_END = 528 * MiB;
constexpr int CW_BAR = 4096;
constexpr int RING_BYTES = 131072, MISC_OFF = RING_BYTES + 320, LDS_BYTES = 147456;

using pg8::Unit; using pg8::u32x4; using pg8::bf16_t;
typedef short s16x4 __attribute__((ext_vector_type(4)));
typedef float f32x16 __attribute__((ext_vector_type(16)));
typedef float f32x2v __attribute__((ext_vector_type(2)));
typedef __bf16 bf16x2_t __attribute__((ext_vector_type(2)));

__device__ __forceinline__ unsigned cvtpk(float lo, float hi) { f32x2v v = {lo, hi}; bf16x2_t b = __builtin_convertvector(v, bf16x2_t); return __builtin_bit_cast(unsigned, b); }
__device__ __forceinline__ float bf2f(unsigned short b) { return __builtin_bit_cast(float, (unsigned)b << 16); }
__device__ __forceinline__ float silu_f(float a) { return a * __builtin_amdgcn_rcpf(1.0f + __builtin_amdgcn_exp2f(-1.4426950408889634f * a)); }
__device__ __forceinline__ int row_sidx(int r) { return r < MP ? (r >> 11) : 8 + ((r - MP) >> 6); }
__device__ __forceinline__ int row_tidx(int r) { return r < MP ? (r & 2047) : 2048 + (r & 63); }
template <int CTRL> __device__ __forceinline__ float dpp_f(float v) { return __builtin_bit_cast(float, __builtin_amdgcn_update_dpp(0, __builtin_bit_cast(int, v), CTRL, 0xF, 0xF, true)); }
__device__ __forceinline__ void swap16(unsigned& a, unsigned& b) { asm volatile("s_nop 1\n\tv_permlane16_swap_b32 %0, %1" : "+v"(a), "+v"(b)); }
__device__ __forceinline__ void swap32(unsigned& a, unsigned& b) { asm volatile("s_nop 1\n\tv_permlane32_swap_b32 %0, %1" : "+v"(a), "+v"(b)); }
__device__ __forceinline__ float xor16_sum(float v) { unsigned a = __builtin_bit_cast(unsigned, v), b = a; swap16(a, b); return __builtin_bit_cast(float, a) + __builtin_bit_cast(float, b); }
__device__ __forceinline__ float xor32_sum(float v) { unsigned a = __builtin_bit_cast(unsigned, v), b = a; swap32(a, b); return __builtin_bit_cast(float, a) + __builtin_bit_cast(float, b); }
__device__ __forceinline__ float xor16_max(float v) { unsigned a = __builtin_bit_cast(unsigned, v), b = a; swap16(a, b); return fmaxf(__builtin_bit_cast(float, a), __builtin_bit_cast(float, b)); }
__device__ __forceinline__ float xor32_max(float v) { unsigned a = __builtin_bit_cast(unsigned, v), b = a; swap32(a, b); return fmaxf(__builtin_bit_cast(float, a), __builtin_bit_cast(float, b)); }
__device__ __forceinline__ float wave_sum(float v) {
    v += dpp_f<0xB1>(v); v += dpp_f<0x4E>(v);
    v += dpp_f<0x124>(v); v += dpp_f<0x128>(v);
    return xor32_sum(xor16_sum(v));
}
__device__ __forceinline__ float wave_max(float v) {
    v = fmaxf(v, dpp_f<0xB1>(v)); v = fmaxf(v, dpp_f<0x4E>(v));
    v = fmaxf(v, dpp_f<0x124>(v)); v = fmaxf(v, dpp_f<0x128>(v));
    return xor32_max(xor16_max(v));
}
__device__ __forceinline__ unsigned off_b(unsigned row, unsigned ch) { return 256u * row + 16u * (ch ^ (((row & 3u) << 2) | ((row >> 2) & 3u))); }
__device__ __forceinline__ unsigned tr_addr(unsigned lane, unsigned R0, unsigned c) {
    const unsigned blk = (lane >> 4) & 1u, q = (lane & 15u) >> 2, p = lane & 3u;
    return off_b(R0 + q, 4u * c + 2u * blk + (p >> 1)) + 8u * (p & 1u);
}
__device__ __forceinline__ s16x4 ds_tr(LAS unsigned char* base, unsigned off) {
    return __builtin_bit_cast(s16x4, __builtin_amdgcn_ds_read_tr16_b64_v4i16((LAS s16x4*)(base + off)));
}
__device__ __forceinline__ bf16x8 cat8(s16x4 lo, s16x4 hi) { return (bf16x8){lo[0], lo[1], lo[2], lo[3], hi[0], hi[1], hi[2], hi[3]}; }
#define MFMA32(a, b, c) __builtin_amdgcn_mfma_f32_32x32x16_bf16((a), (b), (c), 0, 0, 0)
__device__ __forceinline__ int crow(int r, int hi) { return (r & 3) + 8 * (r >> 2) + 4 * hi; }
__device__ __forceinline__ bf16x8 pack_step(const f32x16& x, int s) {
    u32x4 p; p[0] = cvtpk(x[8 * s], x[8 * s + 1]); p[1] = cvtpk(x[8 * s + 2], x[8 * s + 3]); p[2] = cvtpk(x[8 * s + 4], x[8 * s + 5]); p[3] = cvtpk(x[8 * s + 6], x[8 * s + 7]);
    return __builtin_bit_cast(bf16x8, p);
}

struct EpiUp {
    static constexpr bool PERM = true, AFTER_DRAIN = false;
    bf16_t* act;
    __device__ __forceinline__ void operator()(const f32x4 (&acc)[2][2][4][2], const Unit& u, int wr, int wc, int fr, int fq) const {
        asm volatile("" : "+v"(fr), "+v"(fq));
        const int row0 = u.pm * 256 + (u.half == 2 ? 128 : 0) + wr * 64 + fr, col = u.pn * 128 + wc * 32 + 8 * fq;
#pragma unroll
        for (int ai = 0; ai < 2; ++ai) {
            if (ai == 1 && u.half) break;
#pragma unroll
            for (int m = 0; m < 4; ++m) {
                const int row = row0 + ai * 128 + m * 16;
                float o[8];
#pragma unroll
                for (int n = 0; n < 2; ++n)
#pragma unroll
                    for (int e = 0; e < 4; ++e) o[4 * n + e] = silu_f(acc[ai][0][m][n][e]) * acc[ai][1][m][n][e];
                u32x4 w; w.x = cvtpk(o[0], o[1]); w.y = cvtpk(o[2], o[3]); w.z = cvtpk(o[4], o[5]); w.w = cvtpk(o[6], o[7]);
                *(u32x4*)(act + (size_t)row * DFF + col) = w;
                asm volatile("" ::: "memory");
            }
        }
    }
};
struct EpiRes {
    static constexpr bool PERM = true, AFTER_DRAIN = false;
    bf16_t* XB; float* yout; int fin; const float* gate; float fac; bf16_t* partd;
    __device__ __forceinline__ void operator()(const f32x4 (&acc)[2][2][4][2], const Unit& u, int wr, int wc, int fr, int fq) const {
        asm volatile("" : "+v"(fr), "+v"(fq));
        const int row0 = u.pm * 256 + (u.half == 2 ? 128 : 0) + wr * 64 + fr, col0 = u.pn * 256 + wc * 32 + 8 * fq;
        if (u.pm >= 64) {
#pragma unroll
            for (int ai = 0; ai < 2; ++ai)
#pragma unroll
                for (int m = 0; m < 4; ++m) {
                    if (ai == 1 && u.half) continue;
                    const int row = row0 + ai * 128 + m * 16;
                    bf16_t* po = partd + ((size_t)u.aux * MS + (row - MP)) * D + col0;
#pragma unroll
                    for (int bj = 0; bj < 2; ++bj) { const f32x4 p0 = acc[ai][bj][m][0], p1 = acc[ai][bj][m][1];
                        u32x4 w; w.x = cvtpk(p0[0], p0[1]); w.y = cvtpk(p0[2], p0[3]); w.z = cvtpk(p1[0], p1[1]); w.w = cvtpk(p1[2], p1[3]); *(u32x4*)(po + bj * 128) = w; }
                }
            return;
        }
        const float* g = gate + (size_t)((u.pm * 256) >> 11) * NMOD + col0;
#pragma unroll
        for (int ai = 0; ai < 2; ++ai)
#pragma unroll
            for (int bj = 0; bj < 2; ++bj) {
                f32x4 gv[2]; u32x4 xb[4];
#pragma unroll
                for (int n = 0; n < 2; ++n) gv[n] = *(const f32x4*)(g + bj * 128 + n * 4);
#pragma unroll
                for (int m = 0; m < 4; ++m) { const size_t off = (size_t)(row0 + ai * 128 + m * 16) * D + col0 + bj * 128;
                    xb[m] = *(const u32x4*)(XB + off); }
#pragma unroll
                for (int m = 0; m < 4; ++m) { const size_t off = (size_t)(row0 + ai * 128 + m * 16) * D + col0 + bj * 128;
                    f32x4 x0, x1;
                    { x0 = (f32x4){__builtin_bit_cast(float, xb[m][0] << 16), __builtin_bit_cast(float, xb[m][0] & 0xffff0000u), __builtin_bit_cast(float, xb[m][1] << 16), __builtin_bit_cast(float, xb[m][1] & 0xffff0000u)};
                           x1 = (f32x4){__builtin_bit_cast(float, xb[m][2] << 16), __builtin_bit_cast(float, xb[m][2] & 0xffff0000u), __builtin_bit_cast(float, xb[m][3] << 16), __builtin_bit_cast(float, xb[m][3] & 0xffff0000u)}; }
                    const f32x4 y0 = x0 + (gv[0] * fac) * acc[ai][bj][m][0], y1 = x1 + (gv[1] * fac) * acc[ai][bj][m][1];
                    if (fin) { __builtin_nontemporal_store(y0, (f32x4*)(yout + off)); __builtin_nontemporal_store(y1, (f32x4*)(yout + off + 4)); }
                    else { u32x4 w; w.x = cvtpk(y0[0], y0[1]); w.y = cvtpk(y0[2], y0[3]); w.z = cvtpk(y1[0], y1[1]); w.w = cvtpk(y1[2], y1[3]); *(u32x4*)(XB + off) = w; } }
                asm volatile("" ::: "memory");
            }
    }
};
struct TailOrder {
    pg8::StaticOrder P; int G, c, nfull, rem;
    __device__ __forceinline__ void init(int M_, int N_, int G_, int c_) { P.init(M_, N_, G_, c_); G = G_; c = c_; nfull = P.nwg / G_; rem = P.nwg - nfull * G_; }
    __device__ __forceinline__ bool next(int i, Unit& u) const {
        if (i < nfull) return P.next(i, u);
        const int hL = (i - nfull) * G + c; if (hL >= 2 * rem) return false;
        const bool ok = P.at((long)nfull * G + (hL >> 1), u); u.half = 1 + (hL & 1); return ok;
    }
    __device__ __forceinline__ void a_ready(const Unit&) const {}
    __device__ __forceinline__ void done(const Unit&) const {}
};
struct SplitOrder {
    pg8::StaticOrder P; int G, c, np, kt;
    __device__ __forceinline__ void init(int G_, int c_, int ktiles) { P.init(MP, D, G_, c_); G = G_; c = c_; np = (256 + G_ - 1) / G_; kt = ktiles; }
    __device__ __forceinline__ bool next(int i, Unit& u) const {
        const int cnt_p = c < 256 ? (256 - c + G - 1) / G : 0;
        const bool isp = i < cnt_p;
        Unit a; const bool oka = P.at((long)(isp ? i : 0) * G + c, a);
        const int q = (i - cnt_p) * G + c;
        const int sp = q & 7; const bool big = kt == 44; const int step = big ? 6 : 2;
        int kt0 = step * sp; if (big && kt0 > 40) kt0 = 40;
        int nkt = step; if (big && sp >= 6) nkt = 4;
        u.pm = isp ? a.pm : 64 + ((q >> 5) & 7); u.pn = isp ? a.pn : (q >> 3) & 3; u.kt0 = isp ? 0 : kt0; u.nkt = isp ? 0 : nkt; u.aux = isp ? 0 : sp; u.half = 0;
        return isp ? oka : (q >= 0 && q < 256);
    }
    __device__ __forceinline__ void a_ready(const Unit&) const {}
    __device__ __forceinline__ void done(const Unit&) const {}
};
struct EpiIn {
    static constexpr bool PERM = true, AFTER_DRAIN = false;
    bf16_t *RQ, *RK, *RV, *SG, *DQ, *DK, *DV; float *kout_p, *kout_s, *vout_p, *vout_s;
    const float* gqk;
    __device__ __forceinline__ void operator()(const f32x4 (&acc)[2][2][4][2], const Unit& u, int wr, int wc, int fr, int fq) const {
        asm volatile("" : "+v"(fr), "+v"(fq));
        const int row0 = u.pm * 256 + (u.half == 2 ? 128 : 0) + wr * 64 + fr; const int pn = u.pn; const int nai = u.half ? 1 : 2;
        if (pn <= 1) {
            bf16_t* O = pn == 0 ? RQ : RK;
#pragma unroll
            for (int bj = 0; bj < 2; ++bj) {
                const int head = 2 * bj + (wc >> 1);
                const float lg = log2f(1.0f - exp2f(-5.0f - (float)head));
                const int i0 = 16 * (wc & 1) + 4 * fq;
                float rf[4];
#pragma unroll
                for (int k = 0; k < 4; ++k) rf[k] = exp2f(-(float)(i0 + k) * (13.287712379549449f / 31.0f) - 2.651496129472319f);
#pragma unroll
                for (int ai = 0; ai < 2; ++ai)
#pragma unroll
                    for (int m = 0; m < 4; ++m) { if (ai >= nai) continue;
                        const int row = row0 + ai * 128 + m * 16;
                        const float posf = (float)(row < MP ? (row & 2047) : 4096 + (row & 63));
                        float cs[4], sn[4];
#pragma unroll
                        for (int k = 0; k < 4; ++k) { float r = posf * rf[k]; r = r - floorf(r); cs[k] = __builtin_amdgcn_cosf(r); sn[k] = __builtin_amdgcn_sinf(r); }
                        const float ic1 = (float)((row & 63) + 1);
                        const float sc = pn == 0 ? exp2f(lg * ic1) : 0.125f * exp2f(-lg * ic1);
                        const f32x4 v0 = acc[ai][bj][m][0], v1 = acc[ai][bj][m][1];
                        float o[8];
                        o[0] = (v0[0] * cs[0] - v0[1] * sn[0]) * sc; o[1] = (v0[0] * sn[0] + v0[1] * cs[0]) * sc;
                        o[2] = (v0[2] * cs[1] - v0[3] * sn[1]) * sc; o[3] = (v0[2] * sn[1] + v0[3] * cs[1]) * sc;
                        o[4] = (v1[0] * cs[2] - v1[1] * sn[2]) * sc; o[5] = (v1[0] * sn[2] + v1[1] * cs[2]) * sc;
                        o[6] = (v1[2] * cs[3] - v1[3] * sn[3]) * sc; o[7] = (v1[2] * sn[3] + v1[3] * cs[3]) * sc;
                        u32x4 w; w.x = cvtpk(o[0], o[1]); w.y = cvtpk(o[2], o[3]); w.z = cvtpk(o[4], o[5]); w.w = cvtpk(o[6], o[7]);
                        *(u32x4*)(O + ((size_t)(((row >> 6) * 4 + head) * 8 + ((row & 63) >> 5) * 4 + 2 * (wc & 1) + (fq >> 1)) * 512 + (size_t)((row & 31) + 32 * (fq & 1)) * 8)) = w;
                    }
            }
        } else if (pn <= 5) {
            bf16_t* O = pn <= 3 ? RV : SG; const int cb = 256 * ((pn - 2) & 1);
#pragma unroll
            for (int ai = 0; ai < 2; ++ai)
#pragma unroll
                for (int m = 0; m < 4; ++m) { if (ai >= nai) continue;
                    const int row = row0 + ai * 128 + m * 16;
#pragma unroll
                    for (int bj = 0; bj < 2; ++bj) {
                        f32x4 v0 = acc[ai][bj][m][0], v1 = acc[ai][bj][m][1];
                        if (pn >= 4) {
#pragma unroll
                            for (int e = 0; e < 4; ++e) { v0[e] = silu_f(v0[e]); v1[e] = silu_f(v1[e]); }
                        }
                        u32x4 w; w.x = cvtpk(v0[0], v0[1]); w.y = cvtpk(v0[2], v0[3]); w.z = cvtpk(v1[0], v1[1]); w.w = cvtpk(v1[2], v1[3]);
                        *(u32x4*)(O + (size_t)row * 512 + cb + 128 * bj + 32 * wc + 8 * fq) = w;
                    }
                    asm volatile("" ::: "memory");
                }
        } else if (pn <= 9) {
            const bool isq = pn <= 7; const int cb = 256 * ((pn - 6) & 1) + 64 * wc;
            const float* g = gqk + (isq ? 0 : 64);
            float rf[8];
#pragma unroll
            for (int k = 0; k < 8; ++k) rf[k] = exp2f(-(float)(8 * fq + k) * (13.287712379549449f / 32.0f) - 2.651496129472319f);
            const f32x4 g00 = *(const f32x4*)(g + 8 * fq), g01 = *(const f32x4*)(g + 8 * fq + 4), g10 = *(const f32x4*)(g + 32 + 8 * fq), g11 = *(const f32x4*)(g + 32 + 8 * fq + 4);
#pragma unroll
            for (int ai = 0; ai < 2; ++ai)
#pragma unroll
                for (int m = 0; m < 4; ++m) { if (ai >= nai) continue;
                    const int row = row0 + ai * 128 + m * 16;
                    const f32x4 a0 = acc[ai][0][m][0], a1 = acc[ai][0][m][1], b0 = acc[ai][1][m][0], b1 = acc[ai][1][m][1];
                    float ss = 0.f;
#pragma unroll
                    for (int e = 0; e < 4; ++e) ss += a0[e] * a0[e] + a1[e] * a1[e] + b0[e] * b0[e] + b1[e] * b1[e];
                    ss = xor32_sum(xor16_sum(ss));
                    float rs = 1.0f / sqrtf(ss * (1.0f / 64.0f) + EPS);
                    const float posf = (float)(row < MP ? (row & 2047) : 4096 + (row & 63));
                    float cs[8], sn[8];
#pragma unroll
                    for (int k = 0; k < 8; ++k) { float r = posf * rf[k]; r = r - floorf(r); cs[k] = __builtin_amdgcn_cosf(r); sn[k] = __builtin_amdgcn_sinf(r); }
                    float x1[8], x2[8], o1[8], o2[8];
#pragma unroll
                    for (int e = 0; e < 4; ++e) { x1[e] = a0[e] * rs * g00[e]; x1[4 + e] = a1[e] * rs * g01[e]; x2[e] = b0[e] * rs * g10[e]; x2[4 + e] = b1[e] * rs * g11[e]; }
                    const float osc = isq ? C2 : 1.0f;
#pragma unroll
                    for (int j = 0; j < 8; ++j) { o1[j] = (x1[j] * cs[j] - x2[j] * sn[j]) * osc; o2[j] = (x2[j] * cs[j] + x1[j] * sn[j]) * osc; }
                    bf16_t* O = (isq ? DQ : DK) + (size_t)row * 512 + cb + 8 * fq;
                    u32x4 w; w.x = cvtpk(o1[0], o1[1]); w.y = cvtpk(o1[2], o1[3]); w.z = cvtpk(o1[4], o1[5]); w.w = cvtpk(o1[6], o1[7]);
                    *(u32x4*)O = w;
                    w.x = cvtpk(o2[0], o2[1]); w.y = cvtpk(o2[2], o2[3]); w.z = cvtpk(o2[4], o2[5]); w.w = cvtpk(o2[6], o2[7]);
                    *(u32x4*)(O + 32) = w;
                    if (!isq) {
                        float* ko = (row < MP ? kout_p + (size_t)row * 512 : kout_s + (size_t)(row - MP) * 512) + cb + 8 * fq;
                        __builtin_nontemporal_store((f32x4){o1[0], o1[1], o1[2], o1[3]}, (f32x4*)ko); __builtin_nontemporal_store((f32x4){o1[4], o1[5], o1[6], o1[7]}, (f32x4*)(ko + 4));
                        __builtin_nontemporal_store((f32x4){o2[0], o2[1], o2[2], o2[3]}, (f32x4*)(ko + 32)); __builtin_nontemporal_store((f32x4){o2[4], o2[5], o2[6], o2[7]}, (f32x4*)(ko + 36));
                    }
                    asm volatile("" ::: "memory");
                }
        } else {
            const int cb = 256 * ((pn - 10) & 1);
#pragma unroll
            for (int ai = 0; ai < 2; ++ai)
#pragma unroll
                for (int m = 0; m < 4; ++m) { if (ai >= nai) continue;
                    const int row = row0 + ai * 128 + m * 16;
                    float* vo = (row < MP ? vout_p + (size_t)row * 512 : vout_s + (size_t)(row - MP) * 512) + cb;
#pragma unroll
                    for (int bj = 0; bj < 2; ++bj) {
                        const int c = 128 * bj + 32 * wc + 8 * fq;
                        const f32x4 v0 = acc[ai][bj][m][0], v1 = acc[ai][bj][m][1];
                        __builtin_nontemporal_store(v0, (f32x4*)(vo + c)); __builtin_nontemporal_store(v1, (f32x4*)(vo + c + 4));
                        u32x4 w; w.x = cvtpk(v0[0], v0[1]); w.y = cvtpk(v0[2], v0[3]); w.z = cvtpk(v1[0], v1[1]); w.w = cvtpk(v1[2], v1[3]);
                        *(u32x4*)(DV + (size_t)row * 512 + cb + c) = w;
                    }
                    asm volatile("" ::: "memory");
                }
        }
    }
};

__device__ __forceinline__ void transpose_item(const float* __restrict__ W, int K, int N, bf16_t* __restrict__ WT, int dst_row0, int src_col0, int k0, LAS float* scr, int lane) {
    float t[32];
    const float* wp = W + (size_t)(k0 + (lane >> 5)) * N + src_col0 + (lane & 31);
#pragma unroll
    for (int i = 0; i < 32; ++i) t[i] = __builtin_nontemporal_load(wp + (size_t)(2 * i) * N);
#pragma unroll
    for (int i = 0; i < 32; ++i) scr[(2 * i + (lane >> 5)) * 33 + (lane & 31)] = t[i];
    LDS_WAIT(); asm volatile("" ::: "memory");
    const int c = lane & 7;
#pragma unroll
    for (int j = 0; j < 4; ++j) { const int n = (lane >> 3) + 8 * j; const LAS float* s = scr + (8 * c) * 33 + n;
        v4u o; o.x = pk2(s[0 * 33], s[1 * 33]); o.y = pk2(s[2 * 33], s[3 * 33]); o.z = pk2(s[4 * 33], s[5 * 33]); o.w = pk2(s[6 * 33], s[7 * 33]);
        *(GAS v4u*)(WT + (size_t)(dst_row0 + n) * K + k0 + 8 * c) = o; }
    LDS_WAIT(); asm volatile("" ::: "memory");
}
constexpr int I_UP = 16 * 176, I_DN = 44 * 32, I_IN = 16 * 96, I_OUT = 16 * 32, I_LAYER = 2 * I_UP + 2 * I_DN + I_IN + I_OUT;
__device__ __forceinline__ void convert_layer_item(int lay, int j, const float* w_ff_up, const float* w_ff_down, const float* w_in, const float* w_out, unsigned char* ws, LAS float* scr, int lane) {
    int r = j;
    if (r < 2 * I_UP) { const int mat = lay * 2 + r / I_UP; r %= I_UP; const int kb = r / 176, g = r % 176;
        const int pn = g >> 3, bj = (g >> 2) & 1, wc = g & 3;
        transpose_item(w_ff_up + (size_t)mat * D * NUP, D, NUP, (bf16_t*)(ws + WS_WUP) + (size_t)mat * NUP * D, 32 * g, (bj ? DFF : 0) + 128 * pn + 32 * wc, 64 * kb, scr, lane); return; }
    r -= 2 * I_UP;
    if (r < 2 * I_DN) { const int mat = lay * 2 + r / I_DN; r %= I_DN; const int kb = r / 32, g = r % 32;
        transpose_item(w_ff_down + (size_t)mat * DFF * D, DFF, D, (bf16_t*)(ws + WS_WDN) + (size_t)mat * D * DFF, 32 * g, 32 * g, 64 * kb, scr, lane); return; }
    r -= 2 * I_DN;
    if (r < I_IN) { const int kb = r / 96, g = r % 96;
        const int pn = g >> 3, bj = (g >> 2) & 1, wc = g & 3;
        const int src = (pn >= 6 && pn <= 9) ? 256 * pn + 64 * wc + 32 * bj : 32 * g;
        transpose_item(w_in + (size_t)lay * D * DIN, D, DIN, (bf16_t*)(ws + WS_WIN) + (size_t)lay * DIN * D, 32 * g, src, 64 * kb, scr, lane); return; }
    r -= I_IN;
    { const int kb = r / 32, g = r % 32;
        transpose_item(w_out + (size_t)lay * D * D, D, D, (bf16_t*)(ws + WS_WOUT) + (size_t)lay * D * D, 32 * g, 32 * g, 64 * kb, scr, lane); }
}
__device__ __forceinline__ void background_convert(int jb, int je, int rank, int nidle, int wid, const float* w_ff_up, const float* w_ff_down, const float* w_in, const float* w_out, unsigned char* ws, LAS unsigned char* lds, int lane) {
    if (rank < 0) return;
    LAS float* scr = (LAS float*)(lds + wid * 16384);
#pragma unroll 1
    for (int j = jb + rank * NWAVES + wid; j < je; j += nidle * NWAVES) convert_layer_item(1, j, w_ff_up, w_ff_down, w_in, w_out, ws, scr, lane);
}
__device__ __forceinline__ void adaln_item(int item, const float* cp, const float* cs, const float* w_ada, const float* b_ada, float* mod, LAS unsigned char* lds, int tid, int wid, int lane) {
    const int l = item / 144, cg = item % 144, fr = lane & 15, fq = lane >> 4, kb0 = wid * 128;
    LAS unsigned char* Tw = lds + wid * 13312;
    const __amdgpu_buffer_rsrc_t cprs = __builtin_amdgcn_make_buffer_rsrc((void*)cp, 0, 8 * D * 4, 0x00020000), csrs = __builtin_amdgcn_make_buffer_rsrc((void*)cs, 0, 32 * D * 4, 0x00020000);
    const unsigned loff = (unsigned)lane * 4u;
#pragma unroll
    for (int s = 0; s < 40; ++s)
#pragma unroll
        for (int h = 0; h < 2; ++h) { const float c = __builtin_bit_cast(float, __builtin_amdgcn_raw_buffer_load_b32(s < 8 ? cprs : csrs, loff, (unsigned)(((s < 8 ? s : s - 8) * D + kb0 + 64 * h) * 4), 0));
            *(LAS unsigned short*)(Tw + s * 272 + (64 * h + lane) * 2) = (unsigned short)f2bf(c / (1.0f + __expf(-c))); }
    const __amdgpu_buffer_rsrc_t wrs = __builtin_amdgcn_make_buffer_rsrc((void*)w_ada, 0, 2 * D * NMOD * 4, 0x00020000);
    const unsigned voff = (unsigned)((8 * fq) * NMOD + fr) * 4u;
    f32x4 acc[4][3];
#pragma unroll
    for (int nb = 0; nb < 4; ++nb)
#pragma unroll
        for (int sb = 0; sb < 3; ++sb) acc[nb][sb] = (f32x4){0.f, 0.f, 0.f, 0.f};
    LDS_WAIT(); asm volatile("" ::: "memory");
#pragma unroll
    for (int kb = 0; kb < 4; ++kb) {
        bf16x8 yf[4];
#pragma unroll
        for (int nb = 0; nb < 4; ++nb) {
            float w[8];
#pragma unroll
            for (int j = 0; j < 8; ++j) w[j] = __builtin_bit_cast(float, __builtin_amdgcn_raw_buffer_load_b32(wrs, voff, (unsigned)((l * D + kb0 + 32 * kb + j) * NMOD + cg * 64 + 16 * nb) * 4u,   2));
            u32x4 pk; pk.x = cvtpk(w[0], w[1]); pk.y = cvtpk(w[2], w[3]); pk.z = cvtpk(w[4], w[5]); pk.w = cvtpk(w[6], w[7]);
            yf[nb] = __builtin_bit_cast(bf16x8, pk);
        }
        bf16x8 xf[3];
#pragma unroll
        for (int sb = 0; sb < 3; ++sb) xf[sb] = *(const LAS bf16x8*)(Tw + (16 * sb + fr) * 272 + (32 * kb + 8 * fq) * 2);
#pragma unroll
        for (int nb = 0; nb < 4; ++nb)
#pragma unroll
            for (int sb = 0; sb < 3; ++sb) acc[nb][sb] = __builtin_amdgcn_mfma_f32_16x16x32_bf16(xf[sb], yf[nb], acc[nb][sb], 0, 0, 0);
    }
    __syncthreads();
    LAS float* R = (LAS float*)lds;
#pragma unroll
    for (int nb = 0; nb < 4; ++nb)
#pragma unroll
        for (int sb = 0; sb < 3; ++sb)
#pragma unroll
            for (int e = 0; e < 4; ++e) { const int s = 16 * sb + 4 * fq + e; if (s < 40) R[(wid * 40 + s) * 64 + 16 * nb + fr] = acc[nb][sb][e]; }
    __syncthreads();
    for (int idx = tid; idx < 40 * 64; idx += NTHREADS) {
        const int s = idx >> 6, ln = idx & 63; float v = b_ada[(size_t)l * NMOD + cg * 64 + ln];
#pragma unroll
        for (int w = 0; w < 8; ++w) v += R[(w * 40 + s) * 64 + ln];
        mod[((size_t)l * NSEQ + s) * NMOD + cg * 64 + ln] = v;
    }
    __syncthreads();
}
__device__ __forceinline__ void trig_fill(float* trig, int gtid, int gthreads) {
    for (int i = gtid; i < 2112 * 64; i += gthreads) {
        const int pidx = i >> 6, kind = (i >> 5) & 1, j = i & 31;
        const int pos = pidx < 2048 ? pidx : 4096 + (pidx - 2048);
        const double ex = kind == 0 ? (double)j / 31.0 : (double)j / 32.0;
        const float invf = (float)exp2(-ex * 13.287712379549449);
        const float ang = (float)pos * invf;
        const double rev = (double)ang * 0.15915494309189535; const float fr = (float)(rev - floor(rev));
        trig[2 * i] = __builtin_amdgcn_cosf(fr); trig[2 * i + 1] = __builtin_amdgcn_sinf(fr);
    }
}
__device__ __forceinline__ void norm_row_store(const f32x4 (&v)[2][2], const f32x4 (&gv)[2][2], const f32x4 (&sh)[2][2], const f32x4 (&sc1)[2][2], bf16_t* Hrow, int lane) {
    float ss = 0.f;
#pragma unroll
    for (int j = 0; j < 2; ++j)
#pragma unroll
        for (int q = 0; q < 2; ++q) ss += (v[j][q][0] * v[j][q][0] + v[j][q][1] * v[j][q][1]) + (v[j][q][2] * v[j][q][2] + v[j][q][3] * v[j][q][3]);
    const float rs = 1.0f / sqrtf(wave_sum(ss) * (1.0f / D) + EPS);
#pragma unroll
    for (int j = 0; j < 2; ++j) {
        const f32x4 y0 = (v[j][0] * rs) * gv[j][0] * sc1[j][0] + sh[j][0], y1 = (v[j][1] * rs) * gv[j][1] * sc1[j][1] + sh[j][1];
        u32x4 w; w.x = cvtpk(y0[0], y0[1]); w.y = cvtpk(y0[2], y0[3]); w.z = cvtpk(y1[0], y1[1]); w.w = cvtpk(y1[2], y1[3]);
        *(u32x4*)(Hrow + 8 * lane + 512 * j) = w;
    }
}
__device__ __forceinline__ void norm_phase(const float* fp, const float* fs, bf16_t* XB, const float* g, const float* mod_l, int sub, bf16_t* H, int gw, int ngw, int lane,
                                           const bf16_t* partd, const float* pgate, float pfac) {
    f32x4 gv[2][2], sh[2][2], sc1[2][2];
#pragma unroll
    for (int j = 0; j < 2; ++j)
#pragma unroll
        for (int q = 0; q < 2; ++q) gv[j][q] = *(const f32x4*)(g + 8 * lane + 512 * j + 4 * q);
    {
        const int wps = ngw >> 3, seq = gw / wps, idx = gw - seq * wps;
        const float* md = mod_l + (size_t)seq * NMOD + sub * 3 * D + 8 * lane;
#pragma unroll
        for (int j = 0; j < 2; ++j)
#pragma unroll
            for (int q = 0; q < 2; ++q) { sh[j][q] = *(const f32x4*)(md + 512 * j + 4 * q); sc1[j][q] = *(const f32x4*)(md + D + 512 * j + 4 * q) + 1.0f; }
#define NORM_LOAD_ROW(v_, r_) do { _Pragma("unroll") for (int j = 0; j < 2; ++j) { const int c = 8 * lane + 512 * j; \
            if (fp) { v_[j][0] = __builtin_nontemporal_load((const f32x4*)(fp + (size_t)(r_) * D + c)); v_[j][1] = __builtin_nontemporal_load((const f32x4*)(fp + (size_t)(r_) * D + c + 4)); }     \
            else { const u32x4 b = *(const u32x4*)(XB + (size_t)(r_) * D + c); \
                v_[j][0] = (f32x4){__builtin_bit_cast(float, b[0] << 16), __builtin_bit_cast(float, b[0] & 0xffff0000u), __builtin_bit_cast(float, b[1] << 16), __builtin_bit_cast(float, b[1] & 0xffff0000u)}; \
                v_[j][1] = (f32x4){__builtin_bit_cast(float, b[2] << 16), __builtin_bit_cast(float, b[2] & 0xffff0000u), __builtin_bit_cast(float, b[3] << 16), __builtin_bit_cast(float, b[3] & 0xffff0000u)}; } } } while (0)
#define NORM_XB_STORE(v_, r_) do { if (fp) { _Pragma("unroll") for (int j = 0; j < 2; ++j) { u32x4 w; w.x = cvtpk(v_[j][0][0], v_[j][0][1]); w.y = cvtpk(v_[j][0][2], v_[j][0][3]); w.z = cvtpk(v_[j][1][0], v_[j][1][1]); w.w = cvtpk(v_[j][1][2], v_[j][1][3]); \
            *(u32x4*)(XB + (size_t)(r_) * D + 8 * lane + 512 * j) = w; } } } while (0)
#pragma unroll 1
        for (int t = idx; t < 2048; t += 2 * wps) {
            const int ra = seq * 2048 + t, rb = ra + wps; const bool hb = t + wps < 2048;
            f32x4 va[2][2], vb[2][2];
            NORM_LOAD_ROW(va, ra); NORM_LOAD_ROW(vb, hb ? rb : ra);
            NORM_XB_STORE(va, ra); norm_row_store(va, gv, sh, sc1, H + (size_t)ra * D, lane);
            if (hb) { NORM_XB_STORE(vb, rb); norm_row_store(vb, gv, sh, sc1, H + (size_t)rb * D, lane); }
        }
#undef NORM_LOAD_ROW
#undef NORM_XB_STORE
    }
    for (int r = MP + gw; r < M; r += ngw) {
        const float* xf = fs ? fs + (size_t)(r - MP) * D : nullptr;
        const int sidx = row_sidx(r);
        const float* md = mod_l + (size_t)sidx * NMOD + sub * 3 * D + 8 * lane;
#pragma unroll
        for (int j = 0; j < 2; ++j)
#pragma unroll
            for (int q = 0; q < 2; ++q) { sh[j][q] = *(const f32x4*)(md + 512 * j + 4 * q); sc1[j][q] = *(const f32x4*)(md + D + 512 * j + 4 * q) + 1.0f; }
        f32x4 v[2][2];
#pragma unroll
        for (int j = 0; j < 2; ++j) {
            const int c = 8 * lane + 512 * j;
            if (xf) { v[j][0] = __builtin_nontemporal_load((const f32x4*)(xf + c)); v[j][1] = __builtin_nontemporal_load((const f32x4*)(xf + c + 4));
                u32x4 w; w.x = cvtpk(v[j][0][0], v[j][0][1]); w.y = cvtpk(v[j][0][2], v[j][0][3]); w.z = cvtpk(v[j][1][0], v[j][1][1]); w.w = cvtpk(v[j][1][2], v[j][1][3]);
                *(u32x4*)(XB + (size_t)r * D + c) = w; }
            else { const u32x4 b = *(const u32x4*)(XB + (size_t)r * D + c);
                v[j][0] = (f32x4){__builtin_bit_cast(float, b[0] << 16), __builtin_bit_cast(float, b[0] & 0xffff0000u), __builtin_bit_cast(float, b[1] << 16), __builtin_bit_cast(float, b[1] & 0xffff0000u)};
                v[j][1] = (f32x4){__builtin_bit_cast(float, b[2] << 16), __builtin_bit_cast(float, b[2] & 0xffff0000u), __builtin_bit_cast(float, b[3] << 16), __builtin_bit_cast(float, b[3] & 0xffff0000u)}; }
        }
        if (partd != nullptr) {
            const bf16_t* pp = partd + (size_t)(r - MP) * D + 8 * lane; const float* pg = pgate + (size_t)sidx * NMOD + 8 * lane;
#pragma unroll
            for (int j = 0; j < 2; ++j) {
                u32x4 pb[8];
#pragma unroll
                for (int k = 0; k < 8; ++k) pb[k] = *(const u32x4*)(pp + (size_t)k * MS * D + 512 * j);
                f32x4 s0 = {0.f, 0.f, 0.f, 0.f}, s1 = {0.f, 0.f, 0.f, 0.f};
#pragma unroll
                for (int k = 0; k < 8; ++k) {
                    s0 = s0 + (f32x4){__builtin_bit_cast(float, pb[k][0] << 16), __builtin_bit_cast(float, pb[k][0] & 0xffff0000u), __builtin_bit_cast(float, pb[k][1] << 16), __builtin_bit_cast(float, pb[k][1] & 0xffff0000u)};
                    s1 = s1 + (f32x4){__builtin_bit_cast(float, pb[k][2] << 16), __builtin_bit_cast(float, pb[k][2] & 0xffff0000u), __builtin_bit_cast(float, pb[k][3] << 16), __builtin_bit_cast(float, pb[k][3] & 0xffff0000u)}; }
                v[j][0] = v[j][0] + (*(const f32x4*)(pg + 512 * j) * pfac) * s0; v[j][1] = v[j][1] + (*(const f32x4*)(pg + 512 * j + 4) * pfac) * s1;
                u32x4 w; w.x = cvtpk(v[j][0][0], v[j][0][1]); w.y = cvtpk(v[j][0][2], v[j][0][3]); w.z = cvtpk(v[j][1][0], v[j][1][1]); w.w = cvtpk(v[j][1][2], v[j][1][3]);
                *(u32x4*)(XB + (size_t)r * D + 8 * lane + 512 * j) = w;
            }
        }
        norm_row_store(v, gv, sh, sc1, H + (size_t)r * D, lane);
    }
}
__device__ __forceinline__ void final_reduce(const bf16_t* partd, const float* pgate, float pfac, const bf16_t* XB, float* Y, int gw, int ngw, int lane) {
    for (int r = MP + gw; r < M; r += ngw) {
        const bf16_t* pp = partd + (size_t)(r - MP) * D + 8 * lane; const float* pg = pgate + (size_t)row_sidx(r) * NMOD + 8 * lane;
#pragma unroll
        for (int j = 0; j < 2; ++j) {
            const u32x4 b = *(const u32x4*)(XB + (size_t)r * D + 8 * lane + 512 * j);
            u32x4 pb[8];
#pragma unroll
            for (int k = 0; k < 8; ++k) pb[k] = *(const u32x4*)(pp + (size_t)k * MS * D + 512 * j);
            f32x4 s0 = {0.f, 0.f, 0.f, 0.f}, s1 = {0.f, 0.f, 0.f, 0.f};
#pragma unroll
            for (int k = 0; k < 8; ++k) {
                s0 = s0 + (f32x4){__builtin_bit_cast(float, pb[k][0] << 16), __builtin_bit_cast(float, pb[k][0] & 0xffff0000u), __builtin_bit_cast(float, pb[k][1] << 16), __builtin_bit_cast(float, pb[k][1] & 0xffff0000u)};
                s1 = s1 + (f32x4){__builtin_bit_cast(float, pb[k][2] << 16), __builtin_bit_cast(float, pb[k][2] & 0xffff0000u), __builtin_bit_cast(float, pb[k][3] << 16), __builtin_bit_cast(float, pb[k][3] & 0xffff0000u)}; }
            const f32x4 v0 = (f32x4){__builtin_bit_cast(float, b[0] << 16), __builtin_bit_cast(float, b[0] & 0xffff0000u), __builtin_bit_cast(float, b[1] << 16), __builtin_bit_cast(float, b[1] & 0xffff0000u)};
            const f32x4 v1 = (f32x4){__builtin_bit_cast(float, b[2] << 16), __builtin_bit_cast(float, b[2] & 0xffff0000u), __builtin_bit_cast(float, b[3] << 16), __builtin_bit_cast(float, b[3] & 0xffff0000u)};
            float* yo = Y + (size_t)r * D + 8 * lane + 512 * j;
            __builtin_nontemporal_store(v0 + (*(const f32x4*)(pg + 512 * j) * pfac) * s0, (f32x4*)yo); __builtin_nontemporal_store(v1 + (*(const f32x4*)(pg + 512 * j + 4) * pfac) * s1, (f32x4*)(yo + 4));
        }
    }
}

__device__ __forceinline__ int unit_row0(int u) { return u < 1024 ? ((u >> 7) * 2048 + (u & 31) * 64) : MP + ((u - 1024) >> 2) * 64; }
__device__ __forceinline__ int unit_head(int u) { return u < 1024 ? ((u >> 5) & 3) : (u & 3); }
__device__ __forceinline__ void stage_tile_wave(const bf16_t* src, int row0, int pitch, int col0, LAS unsigned char* img, int lane) {
#pragma unroll
    for (int i = 0; i < 16; ++i) { const int n = lane + 64 * i, row = n >> 4, ch = n & 15;
        const u32x4 v = *(const u32x4*)(src + (size_t)(row0 + row) * pitch + col0 + ch * 8);
        *(LAS u32x4*)(img + off_b(row, ch)) = v; }
}
__device__ __forceinline__ void stage_tile_dma(const bf16_t* src, int row0, int pitch, int col0, LAS unsigned char* img, int lane) {
#pragma unroll
    for (int i = 0; i < 16; ++i) { const int n = lane + 64 * i, row = n >> 4, ch = (n & 15) ^ (((row & 3) << 2) | ((row >> 2) & 3));
        __builtin_amdgcn_global_load_lds((const unsigned*)(src + (size_t)(row0 + row) * pitch + col0 + ch * 8), (LAS unsigned*)(img + i * 1024), 16, 0, 0); }
}
#define VM_WAIT0() asm volatile("s_waitcnt vmcnt(0)" ::: "memory")
__device__ __forceinline__ void ret_kv_item(int item, const bf16_t* RK, const bf16_t* RV, unsigned short* KV, LAS unsigned char* img, int lane) {
    const int u = item >> 1, eh = item & 1, r0 = unit_row0(u), h = unit_head(u), hi = lane >> 5, l32 = lane & 31;
    const bf16_t* kt = RK + (size_t)((r0 >> 6) * 4 + h) * 4096;
#pragma unroll
    for (int i = 0; i < 8; ++i) __builtin_amdgcn_global_load_lds((const unsigned*)(kt + i * 512 + lane * 8), (LAS unsigned*)(img + i * 1024), 16, 0, 0);
#pragma unroll
    for (int i = 0; i < 8; ++i) __builtin_amdgcn_global_load_lds((const unsigned*)(RV + (size_t)(r0 + 8 * i + (lane >> 3)) * 512 + h * 128 + eh * 64 + (lane & 7) * 8), (LAS unsigned*)(img + 8192 + i * 1024), 16, 0, 0);
    VM_WAIT0();
    const int blk = (lane >> 4) & 1, q = (lane & 15) >> 2, p = lane & 3;
    f32x16 acc[2][2];
#pragma unroll
    for (int dt = 0; dt < 2; ++dt)
#pragma unroll
        for (int et = 0; et < 2; ++et) acc[dt][et] = (f32x16){};
#pragma unroll
    for (int s = 0; s < 4; ++s) {
        bf16x8 ka[2], vb[2];
#pragma unroll
        for (int dt = 0; dt < 2; ++dt) {
            const int d = 32 * dt + 16 * blk + 4 * p;
            s16x4 t[2];
#pragma unroll
            for (int t2 = 0; t2 < 2; ++t2) { const int j = 16 * s + 8 * hi + 4 * t2 + q;
                t[t2] = ds_tr(img, (unsigned)((((j >> 5) * 4 + (d >> 4)) * 1024) + (((j & 31) + 32 * ((d >> 3) & 1)) * 16) + (d & 7) * 2)); }
            ka[dt] = cat8(t[0], t[1]);
        }
#pragma unroll
        for (int et = 0; et < 2; ++et) {
            s16x4 t[2];
#pragma unroll
            for (int t2 = 0; t2 < 2; ++t2) { const int j = 16 * s + 8 * hi + 4 * t2 + q; t[t2] = ds_tr(img, (unsigned)(8192 + j * 128 + (32 * et + 16 * blk + 4 * p) * 2)); }
            vb[et] = cat8(t[0], t[1]);
        }
#pragma unroll
        for (int dt = 0; dt < 2; ++dt)
#pragma unroll
            for (int et = 0; et < 2; ++et) acc[dt][et] = MFMA32(ka[dt], vb[et], acc[dt][et]);
    }
    unsigned short* o = KV + (size_t)u * 8192 + eh * 64;
#pragma unroll
    for (int dt = 0; dt < 2; ++dt)
#pragma unroll
        for (int et = 0; et < 2; ++et)
#pragma unroll
            for (int r = 0; r < 16; ++r) o[(32 * dt + crow(r, hi)) * 128 + 32 * et + l32] = (unsigned short)f2bf(acc[dt][et][r]);
    LDS_WAIT(); asm volatile("" ::: "memory");
}
__device__ __forceinline__ void ret_out_item(int item, const bf16_t* __restrict__ RQ, const bf16_t* __restrict__ RK, const bf16_t* __restrict__ RV, const bf16_t* __restrict__ SG, const bf16_t* __restrict__ ST, bf16_t* __restrict__ MIX, LAS unsigned char* img, int lane) {
    const int u = item >> 1, it = item & 1, r0 = unit_row0(u), h = unit_head(u), hi = lane >> 5, l32 = lane & 31;
    bf16x8 qf[4], kf[2][4], sa[4][4];
    const bf16_t* qt = RQ + (size_t)((r0 >> 6) * 4 + h) * 4096; const bf16_t* kt = RK + (size_t)((r0 >> 6) * 4 + h) * 4096;
#pragma unroll
    for (int s = 0; s < 4; ++s) qf[s] = *(const bf16x8*)(qt + (it * 4 + s) * 512 + lane * 8);
#pragma unroll
    for (int jt = 0; jt < 2; ++jt)
#pragma unroll
        for (int s = 0; s < 4; ++s) kf[jt][s] = *(const bf16x8*)(kt + ((jt <= it ? jt : 0) * 4 + s) * 512 + lane * 8);
    const bf16_t* stp = ST + (size_t)u * 8192;
#pragma unroll
    for (int et = 0; et < 4; ++et)
#pragma unroll
        for (int s = 0; s < 4; ++s) sa[et][s] = *(const bf16x8*)(stp + (et * 4 + s) * 512 + lane * 8);
    stage_tile_dma(RV, r0, 512, h * 128, img, lane);
    f32x16 o[4];
#pragma unroll
    for (int et = 0; et < 4; ++et) {
        o[et] = (f32x16){};
#pragma unroll
        for (int s = 0; s < 4; ++s) o[et] = MFMA32(sa[et][s], qf[s], o[et]);
    }
    f32x16 p[2];
#pragma unroll
    for (int jt = 0; jt < 2; ++jt) {
        p[jt] = (f32x16){};
        if (jt <= it) {
#pragma unroll
            for (int s = 0; s < 4; ++s) p[jt] = MFMA32(kf[jt][s], qf[s], p[jt]);
            if (jt == it) {
#pragma unroll
                for (int r = 0; r < 16; ++r) if (crow(r, hi) > l32) p[jt][r] = 0.f;
            }
        }
    }
    VM_WAIT0();
#pragma unroll
    for (int jt = 0; jt < 2; ++jt) {
        if (jt <= it) {
#pragma unroll
            for (int s2 = 0; s2 < 2; ++s2) {
                const bf16x8 xb = pack_step(p[jt], s2);
#pragma unroll
                for (int et = 0; et < 4; ++et) {
                    const bf16x8 va = cat8(ds_tr(img, tr_addr(lane, 32 * jt + 16 * s2 + 4 * hi, et)), ds_tr(img, tr_addr(lane, 32 * jt + 16 * s2 + 8 + 4 * hi, et)));
                    o[et] = MFMA32(va, xb, o[et]);
                }
            }
        }
    }
    float ss = 0.f;
#pragma unroll
    for (int et = 0; et < 4; ++et)
#pragma unroll
        for (int r = 0; r < 16; ++r) ss += o[et][r] * o[et][r];
    ss = xor32_sum(ss);
    const float rs = 1.0f / sqrtf(ss * (1.0f / 128.0f) + EPS);
    LDS_WAIT(); asm volatile("" ::: "memory");
#pragma unroll
    for (int et = 0; et < 4; ++et)
#pragma unroll
        for (int rg = 0; rg < 4; ++rg) {
            const int e = 32 * et + 8 * rg + 4 * hi;
            *(LAS unsigned long long*)(img + l32 * 264 + e * 2) = (unsigned long long)cvtpk(o[et][4 * rg] * rs, o[et][4 * rg + 1] * rs) | ((unsigned long long)cvtpk(o[et][4 * rg + 2] * rs, o[et][4 * rg + 3] * rs) << 32);
        }
    LDS_WAIT(); asm volatile("" ::: "memory");
    u32x4 gv[8];
#pragma unroll
    for (int k = 0; k < 8; ++k) gv[k] = *(const u32x4*)(SG + (size_t)(r0 + 32 * it + 4 * k + (lane >> 4)) * 512 + h * 128 + (lane & 15) * 8);
#pragma unroll
    for (int k = 0; k < 8; ++k) {
        const int rr = 4 * k + (lane >> 4), c16 = lane & 15;
        const unsigned long long a0 = *(const LAS unsigned long long*)(img + rr * 264 + c16 * 16), a1 = *(const LAS unsigned long long*)(img + rr * 264 + c16 * 16 + 8);
        const unsigned ov[4] = {(unsigned)a0, (unsigned)(a0 >> 32), (unsigned)a1, (unsigned)(a1 >> 32)};
        u32x4 w;
#pragma unroll
        for (int j = 0; j < 4; ++j) w[j] = cvtpk(__builtin_bit_cast(float, ov[j] << 16) * __builtin_bit_cast(float, gv[k][j] << 16), __builtin_bit_cast(float, ov[j] & 0xffff0000u) * __builtin_bit_cast(float, gv[k][j] & 0xffff0000u));
        *(u32x4*)(MIX + (size_t)(r0 + 32 * it + rr) * D + h * 128 + c16 * 8) = w;
    }
    LDS_WAIT(); asm volatile("" ::: "memory");
}
__device__ __forceinline__ void scan_phase(const unsigned short* __restrict__ KV, bf16_t* __restrict__ SC, const float* __restrict__ state_l, float* __restrict__ sp_l, float* __restrict__ ss_l, int gtid, int gthreads, int wtid) {
    for (int i = wtid; i < 32 * 1024; i += gthreads) {
        const int bh = i >> 10, dg = (i >> 7) & 7, e = i & 127, h = bh & 3;
        const float g64 = exp2f(64.0f * log2f(1.0f - exp2f(-5.0f - (float)h)));
        float S[8];
#pragma unroll
        for (int k = 0; k < 8; ++k) S[k] = 0.f;
        const unsigned short* kvp = KV + (size_t)bh * 32 * 8192 + (size_t)(8 * dg) * 128 + e; bf16_t* scp = SC + (size_t)bh * 32 * 8192 + (size_t)(((e >> 5) * 4 + (dg >> 1)) * 512 + ((e & 31) + 32 * (dg & 1)) * 8);
#pragma unroll 1
        for (int c4 = 0; c4 < 32; c4 += 8) {
            float kv[8][8];
#pragma unroll
            for (int q = 0; q < 8; ++q)
#pragma unroll
                for (int k = 0; k < 8; ++k) kv[q][k] = bf2f(kvp[(size_t)(c4 + q) * 8192 + k * 128]);
#pragma unroll
            for (int q = 0; q < 8; ++q) {
                u32x4 w; w.x = cvtpk(S[0], S[1]); w.y = cvtpk(S[2], S[3]); w.z = cvtpk(S[4], S[5]); w.w = cvtpk(S[6], S[7]);
                *(u32x4*)(scp + (size_t)(c4 + q) * 8192) = w;
#pragma unroll
                for (int k = 0; k < 8; ++k) S[k] = (S[k] + kv[q][k]) * g64;
            }
        }
#pragma unroll
        for (int k = 0; k < 8; ++k) __builtin_nontemporal_store(S[k], sp_l + (size_t)bh * 8192 + (size_t)(8 * dg + k) * 128 + e);
    }
    for (int i = gtid; i < 128 * 1024; i += gthreads) {
        const int bh = i >> 10, dg = (i >> 7) & 7, e = i & 127, h = bh & 3;
        const float g64 = exp2f(64.0f * log2f(1.0f - exp2f(-5.0f - (float)h)));
        const size_t u = 1024 + bh; const size_t eo = (size_t)(8 * dg) * 128 + e;
        float S[8], kv[8];
#pragma unroll
        for (int k = 0; k < 8; ++k) { S[k] = __builtin_nontemporal_load(state_l + (size_t)bh * 8192 + eo + k * 128); kv[k] = bf2f(KV[u * 8192 + eo + k * 128]); }
#pragma unroll
        for (int k = 0; k < 8; ++k) __builtin_nontemporal_store((S[k] + kv[k]) * g64, ss_l + (size_t)bh * 8192 + eo + k * 128);
    }
}

__device__ __forceinline__ void st_sample_init(bf16_t* __restrict__ SC, const float* __restrict__ state_l, int gtid, int gthreads) {
    for (int i = gtid; i < 128 * 1024; i += gthreads) {
        const int bh = i >> 10, dg = (i >> 7) & 7, e = i & 127;
        const size_t eo = (size_t)(8 * dg) * 128 + e;
        float S[8];
#pragma unroll
        for (int k = 0; k < 8; ++k) S[k] = __builtin_nontemporal_load(state_l + (size_t)bh * 8192 + eo + k * 128);
        u32x4 w; w.x = cvtpk(S[0], S[1]); w.y = cvtpk(S[2], S[3]); w.z = cvtpk(S[4], S[5]); w.w = cvtpk(S[6], S[7]);
        *(u32x4*)(SC + (size_t)(1024 + bh) * 8192 + (size_t)(((e >> 5) * 4 + (dg >> 1)) * 512 + ((e & 31) + 32 * (dg & 1)) * 8)) = w;
    }
}

#define BAR_LDS() asm volatile("s_waitcnt lgkmcnt(0)\n\ts_barrier" ::: "memory")
__device__ __forceinline__ void glds16(const void* gsrc, unsigned lds_dst) { unsigned keep;
    asm volatile("s_mov_b32 %0, m0\n\ts_mov_b32 m0, %2\n\ts_nop 0\n\tglobal_load_lds_dwordx4 %1, off\n\ts_mov_b32 m0, %0" : "=&s"(keep) : "v"(gsrc), "s"(lds_dst) : "memory"); }
template <int NJT, bool ONLINE>
__device__ __forceinline__ void attn_tile(LAS unsigned char* kimg, LAS unsigned char* vimg, const bf16x8 (&qf)[4], const unsigned (&kaddr)[4], const unsigned (&vaddr)[4][2], f32x16 (&o)[4], float& l_acc, float& m_run, float negm0) {
    f32x16 p[NJT];
#pragma unroll
    for (int jt = 0; jt < NJT; ++jt) {
        f32x16 c;
#pragma unroll
        for (int r = 0; r < 16; ++r) c[r] = ONLINE ? 0.f : negm0;
#pragma unroll
        for (int s = 0; s < 4; ++s) {
            const bf16x8 kf = *(const LAS bf16x8*)(kimg + kaddr[s] + 8192 * jt);
            c = MFMA32(kf, qf[s], c);
        }
        p[jt] = c;
    }
    if (ONLINE) {
        float mx = -1e30f;
#pragma unroll
        for (int jt = 0; jt < NJT; ++jt)
#pragma unroll
            for (int r = 0; r < 16; ++r) mx = fmaxf(mx, p[jt][r]);
        mx = xor32_max(mx);
        const float mn = fmaxf(m_run, mx);
        const float al = __builtin_amdgcn_exp2f(m_run - mn);
        m_run = mn; l_acc *= al;
#pragma unroll
        for (int et = 0; et < 4; ++et)
#pragma unroll
            for (int r = 0; r < 16; ++r) o[et][r] *= al;
#pragma unroll
        for (int jt = 0; jt < NJT; ++jt)
#pragma unroll
            for (int r = 0; r < 16; ++r) p[jt][r] -= mn;
    }
    float ls = 0.f;
#pragma unroll
    for (int jt = 0; jt < NJT; ++jt)
#pragma unroll
        for (int r = 0; r < 16; ++r) { p[jt][r] = __builtin_amdgcn_exp2f(p[jt][r]); ls += p[jt][r]; }
    l_acc += ls;
#pragma unroll
    for (int jt = 0; jt < NJT; ++jt)
#pragma unroll
        for (int s2 = 0; s2 < 2; ++s2) {
            const bf16x8 xb = pack_step(p[jt], s2);
#pragma unroll
            for (int et = 0; et < 4; ++et) {
                const bf16x8 va = cat8(ds_tr(vimg, vaddr[et][0] + 256 * (32 * jt + 16 * s2)), ds_tr(vimg, vaddr[et][1] + 256 * (32 * jt + 16 * s2)));
                o[et] = MFMA32(va, xb, o[et]);
            }
        }
}
__device__ __forceinline__ void diff_finish(const f32x16 (&O)[4], size_t row, int h, const float* gsub, float lscale, bf16_t* MIX, int lane) {
    const int hi = lane >> 5;
    float ss = 0.f;
#pragma unroll
    for (int et = 0; et < 4; ++et)
#pragma unroll
        for (int r = 0; r < 16; ++r) ss += O[et][r] * O[et][r];
    ss = xor32_sum(ss);
    const float rs = lscale / sqrtf(ss * (1.0f / 128.0f) + EPS);
#pragma unroll
    for (int et = 0; et < 4; ++et)
#pragma unroll
        for (int rg = 0; rg < 4; ++rg) {
            const int e = 32 * et + 8 * rg + 4 * hi;
            const f32x4 g = *(const f32x4*)(gsub + e);
            const unsigned long long w = (unsigned long long)cvtpk(O[et][4 * rg] * rs * g[0], O[et][4 * rg + 1] * rs * g[1]) | ((unsigned long long)cvtpk(O[et][4 * rg + 2] * rs * g[2], O[et][4 * rg + 3] * rs * g[3]) << 32);
            *(unsigned long long*)(MIX + row * D + 512 + h * 128 + e) = w;
        }
}
__device__ __forceinline__ void attn_prompt_unit(int b, int h, int qb, const bf16_t* DQ, const bf16_t* DK, const bf16_t* DV, bf16_t* MIX, const float* gsub, float lam, float lscale, float negm0,
                                                 LAS unsigned char* lds, int tid, int wid, int lane) {
    asm volatile("" : "+v"(lane), "+v"(tid));
    const int sub = wid >> 2, iw = wid & 3, hi = lane >> 5, l32 = lane & 31;
    const int rowb = b * 2048, q0 = qb * 128 + 32 * iw;
    const int my_tiles = (q0 >> 6) + 1, NT = 2 * qb + 2;
    bf16x8 qf[4];
#pragma unroll
    for (int s = 0; s < 4; ++s) qf[s] = *(const bf16x8*)(DQ + (size_t)(rowb + q0 + l32) * 512 + h * 128 + sub * 64 + 16 * s + 8 * hi);
    f32x16 o[4];
#pragma unroll
    for (int et = 0; et < 4; ++et) o[et] = (f32x16){};
    float l_acc = 0.f, m_run = 0.f;
    unsigned kaddr[4], vaddr[4][2];
#pragma unroll
    for (int s = 0; s < 4; ++s) kaddr[s] = off_b(l32, sub * 8 + 2 * s + hi);
#pragma unroll
    for (int et = 0; et < 4; ++et) { vaddr[et][0] = tr_addr(lane, 4 * hi, et); vaddr[et][1] = tr_addr(lane, 8 + 4 * hi, et); }
    const int chunk = (lane & 15) ^ ((((lane >> 4) & 3) << 2) | (wid & 3));
    const unsigned goff = (unsigned)((((wid * 4 + (lane >> 4)) * 512) + h * 128 + chunk * 8) * 2);
    const char* kbase = (const char*)(DK + (size_t)rowb * 512); const char* vbase = (const char*)(DV + (size_t)rowb * 512);
#define DMA_TILE(t_, bufoff_) do { const size_t to_ = (size_t)(t_) * 65536; _Pragma("unroll") for (int i_ = 0; i_ < 2; ++i_) { \
        glds16(kbase + to_ + i_ * 32768 + goff, lds0 + (unsigned)((bufoff_) + (i_ * 8 + wid) * 1024)); \
        glds16(vbase + to_ + i_ * 32768 + goff, lds0 + (unsigned)((bufoff_) + 16384 + (i_ * 8 + wid) * 1024)); } } while (0)
    const unsigned lds0 = (unsigned)(size_t)lds;
    asm volatile("" : "+v"(qf[0]), "+v"(qf[1]), "+v"(qf[2]), "+v"(qf[3]));
    DMA_TILE(0, 0); DMA_TILE(1, 32768);
#define ATT_STEP(t_, cur_, nx2_) do { \
        if ((t_) + 1 < NT) asm volatile("s_waitcnt vmcnt(4)" ::: "memory"); else asm volatile("s_waitcnt vmcnt(0)" ::: "memory"); \
        BAR_LDS(); \
        if ((t_) + 2 < NT) DMA_TILE((t_) + 2, nx2_); \
        if ((t_) < my_tiles) attn_tile<2, false>(lds + (cur_), lds + (cur_) + 16384, qf, kaddr, vaddr, o, l_acc, m_run, negm0); } while (0)
#pragma unroll 1
    for (int t = 0; t < NT; t += 3) {
        ATT_STEP(t, 0, 65536);
        if (t + 1 < NT) ATT_STEP(t + 1, 32768, 0);
        if (t + 2 < NT) ATT_STEP(t + 2, 65536, 32768);
    }
#undef ATT_STEP
#undef DMA_TILE
    BAR_LDS();
    l_acc = xor32_sum(l_acc);
    const float il = 1.0f / l_acc;
    LAS float* X = (LAS float*)lds + iw * 4096;
    if (sub == 1) {
        const float f = il * lam;
#pragma unroll
        for (int et = 0; et < 4; ++et)
#pragma unroll
            for (int r = 0; r < 16; ++r) X[(et * 16 + r) * 64 + lane] = o[et][r] * f;
    }
    BAR_LDS();
    if (sub == 0) {
#pragma unroll
        for (int et = 0; et < 4; ++et)
#pragma unroll
            for (int r = 0; r < 16; ++r) o[et][r] = o[et][r] * il - X[(et * 16 + r) * 64 + lane];
        diff_finish(o, (size_t)(rowb + q0 + l32), h, gsub, lscale, MIX, lane);
    }
    BAR_LDS();
}
__device__ __forceinline__ void attn_sample_unit(int bh, const float* ck_l, const float* cv_l, const bf16_t* DQ, const bf16_t* DK, const bf16_t* DV, bf16_t* MIX, const float* gsub, float lam, float lscale,
                                                 LAS unsigned char* lds, int tid, int wid, int lane) {
    asm volatile("" : "+v"(lane), "+v"(tid));
    const int bs = bh >> 2, h = bh & 3;
    const int sub = wid >> 2, it = (wid >> 1) & 1, jh = wid & 1, hi = lane >> 5, l32 = lane & 31;
    const int rowq = MP + bs * 64;
    bf16x8 qf[4];
#pragma unroll
    for (int s = 0; s < 4; ++s) qf[s] = *(const bf16x8*)(DQ + (size_t)(rowq + 32 * it + l32) * 512 + h * 128 + sub * 64 + 16 * s + 8 * hi);
    f32x16 o[4];
#pragma unroll
    for (int et = 0; et < 4; ++et) o[et] = (f32x16){};
    float l_acc = 0.f, m_run = -1e30f;
    unsigned kaddr[4], vaddr[4][2];
#pragma unroll
    for (int s = 0; s < 4; ++s) kaddr[s] = off_b(l32, sub * 8 + 2 * s + hi);
#pragma unroll
    for (int et = 0; et < 4; ++et) { vaddr[et][0] = tr_addr(lane, 4 * hi, et); vaddr[et][1] = tr_addr(lane, 8 + 4 * hi, et); }
    const unsigned jo = 8192u * (unsigned)jh;
    const char* kb = (const char*)(ck_l + (size_t)bs * 4096 * 512 + h * 128);
    const char* vb = (const char*)(cv_l + (size_t)bs * 4096 * 512 + h * 128);
    const unsigned voff = (unsigned)(((tid >> 5) * 512 + (tid & 31) * 4) * 4);
    const unsigned wof = off_b((unsigned)(tid >> 5), (unsigned)((tid & 31) >> 1)) + 8u * (unsigned)(tid & 1);
    f32x4 kx[4], vx[4], ky[4], vy[4];
#define LOAD_TILE(tt_, kr, vr) do { const char* kt_ = kb + (size_t)(tt_) * (64 * 2048); const char* vt_ = vb + (size_t)(tt_) * (64 * 2048); \
        _Pragma("unroll") for (int k_ = 0; k_ < 4; ++k_) { kr[k_] = __builtin_nontemporal_load((const f32x4*)(kt_ + k_ * 32768 + voff)); vr[k_] = __builtin_nontemporal_load((const f32x4*)(vt_ + k_ * 32768 + voff)); } } while (0)
#define WRITE_TILE(bf, kr, vr) do { _Pragma("unroll") for (int k_ = 0; k_ < 4; ++k_) { \
            *(LAS unsigned long long*)(lds + (bf) * 32768 + k_ * 4096 + wof) = (unsigned long long)cvtpk(kr[k_][0], kr[k_][1]) | ((unsigned long long)cvtpk(kr[k_][2], kr[k_][3]) << 32); \
            *(LAS unsigned long long*)(lds + (bf) * 32768 + 16384 + k_ * 4096 + wof) = (unsigned long long)cvtpk(vr[k_][0], vr[k_][1]) | ((unsigned long long)cvtpk(vr[k_][2], vr[k_][3]) << 32); } } while (0)
    LOAD_TILE(0, kx, vx); WRITE_TILE(0, kx, vx); BAR_LDS();
    LOAD_TILE(1, kx, vx);
#pragma unroll 1
    for (int tt = 0; tt < 64; tt += 2) {
        if (tt + 2 < 64) LOAD_TILE(tt + 2, ky, vy);
        attn_tile<1, true>(lds + jo, lds + 16384 + jo, qf, kaddr, vaddr, o, l_acc, m_run, 0.f);
        WRITE_TILE(1, kx, vx); BAR_LDS();
        if (tt + 3 < 64) LOAD_TILE(tt + 3, kx, vx);
        attn_tile<1, true>(lds + 32768 + jo, lds + 32768 + 16384 + jo, qf, kaddr, vaddr, o, l_acc, m_run, 0.f);
        if (tt + 2 < 64) WRITE_TILE(0, ky, vy);
        BAR_LDS();
    }
#undef LOAD_TILE
#undef WRITE_TILE
    {
#pragma unroll
        for (int k_ = 0; k_ < 2; ++k_) { const size_t ro_ = (size_t)(rowq + (tid >> 4) + 32 * k_) * 512 + h * 128 + (tid & 15) * 8; const unsigned of_ = off_b((unsigned)((tid >> 4) + 32 * k_), (unsigned)(tid & 15));
            *(LAS u32x4*)(lds + of_) = *(const u32x4*)(DK + ro_); *(LAS u32x4*)(lds + 16384 + of_) = *(const u32x4*)(DV + ro_); }
        BAR_LDS();
        attn_tile<1, true>(lds + jo, lds + 16384 + jo, qf, kaddr, vaddr, o, l_acc, m_run, 0.f);
        BAR_LDS();
    }
    l_acc = xor32_sum(l_acc);
    LAS float* XP = (LAS float*)lds + (wid >> 1) * (66 * 64);
    if (jh == 1) {
#pragma unroll
        for (int et = 0; et < 4; ++et)
#pragma unroll
            for (int r = 0; r < 16; ++r) XP[(et * 16 + r) * 64 + lane] = o[et][r];
        XP[64 * 64 + lane] = m_run; XP[65 * 64 + lane] = l_acc;
    }
    BAR_LDS();
    if (jh == 0) {
        const float m2 = XP[64 * 64 + lane], l2 = XP[65 * 64 + lane];
        const float mm = fmaxf(m_run, m2), w1 = __builtin_amdgcn_exp2f(m_run - mm), w2 = __builtin_amdgcn_exp2f(m2 - mm);
        const float iL = (sub == 0 ? 1.0f : lam) / (w1 * l_acc + w2 * l2);
        const float a1 = w1 * iL, a2 = w2 * iL;
#pragma unroll
        for (int et = 0; et < 4; ++et)
#pragma unroll
            for (int r = 0; r < 16; ++r) o[et][r] = a1 * o[et][r] + a2 * XP[(et * 16 + r) * 64 + lane];
    }
    BAR_LDS();
    LAS float* XS = (LAS float*)lds + it * 4096;
    if (jh == 0 && sub == 1) {
#pragma unroll
        for (int et = 0; et < 4; ++et)
#pragma unroll
            for (int r = 0; r < 16; ++r) XS[(et * 16 + r) * 64 + lane] = o[et][r];
    }
    BAR_LDS();
    if (jh == 0 && sub == 0) {
#pragma unroll
        for (int et = 0; et < 4; ++et)
#pragma unroll
            for (int r = 0; r < 16; ++r) o[et][r] -= XS[(et * 16 + r) * 64 + lane];
        diff_finish(o, (size_t)(rowq + 32 * it + l32), h, gsub, lscale, MIX, lane);
    }
    BAR_LDS();
}
__device__ __forceinline__ void attn_sample_combine(int item, const float* __restrict__ PART, bf16_t* __restrict__ MIX, const float* gsub, float lam, float lscale, LAS float* xs, int wid, int lane) {
    const int bh = item >> 1, it = item & 1, bs = bh >> 2, h = bh & 3, l32 = lane & 31, hi = lane >> 5;
    const float* P0 = PART + ((size_t)(bh * 2) * 8 + it * 2) * (66 * 64) + lane;
    LAS float* red = xs + 64 * 64;
    float w[8];
#pragma unroll
    for (int sub = 0; sub < 2; ++sub) {
        float m[4], l[4];
#pragma unroll
        for (int k = 0; k < 4; ++k) { const float* q = P0 + (size_t)((k >> 1) * 8 + sub * 4 + (k & 1)) * (66 * 64); m[k] = q[64 * 64]; l[k] = q[65 * 64]; }
        const float mm = fmaxf(fmaxf(m[0], m[1]), fmaxf(m[2], m[3]));
        float L = 0.f;
#pragma unroll
        for (int k = 0; k < 4; ++k) { w[sub * 4 + k] = __builtin_amdgcn_exp2f(m[k] - mm); L += w[sub * 4 + k] * l[k]; }
        const float iL = (sub == 0 ? 1.0f : -lam) / L;
#pragma unroll
        for (int k = 0; k < 4; ++k) w[sub * 4 + k] *= iL;
    }
    float pv[8][8];
#pragma unroll
    for (int k8 = 0; k8 < 8; ++k8)
#pragma unroll
        for (int j = 0; j < 8; ++j) pv[k8][j] = P0[(size_t)((((j & 3) >> 1) * 8) + (j >> 2) * 4 + (j & 1)) * (66 * 64) + (size_t)(8 * wid + k8) * 64];
    float ss = 0.f;
#pragma unroll
    for (int k8 = 0; k8 < 8; ++k8) { float v = 0.f;
#pragma unroll
        for (int j = 0; j < 8; ++j) v += w[j] * pv[k8][j];
        ss += v * v; xs[(8 * wid + k8) * 64 + lane] = v; }
    red[wid * 64 + lane] = ss;
    __syncthreads();
    float st = 0.f;
#pragma unroll
    for (int k = 0; k < 8; ++k) st += red[k * 64 + lane];
    st = xor32_sum(st);
    const float rs = lscale / sqrtf(st * (1.0f / 128.0f) + EPS);
    const size_t row = (size_t)(MP + bs * 64 + 32 * it + l32);
#pragma unroll
    for (int k2 = 0; k2 < 2; ++k2) {
        const int q = 2 * wid + k2, e = 32 * (q >> 2) + 8 * (q & 3) + 4 * hi;
        const f32x4 g = *(const f32x4*)(gsub + e);
        const float v0 = xs[(4 * q) * 64 + lane], v1 = xs[(4 * q + 1) * 64 + lane], v2 = xs[(4 * q + 2) * 64 + lane], v3 = xs[(4 * q + 3) * 64 + lane];
        const unsigned long long wv = (unsigned long long)cvtpk(v0 * rs * g[0], v1 * rs * g[1]) | ((unsigned long long)cvtpk(v2 * rs * g[2], v3 * rs * g[3]) << 32);
        *(unsigned long long*)(MIX + row * D + 512 + h * 128 + e) = wv;
    }
    __syncthreads();
}

struct Args { const float* in[17]; float* out; unsigned char* ws; int ph_lo, ph_hi; };
constexpr int NPL = 12;
constexpr int NPHASES = 2 + 2 * NPL;

__global__ void __launch_bounds__(NTHREADS, 2) fwd_kernel(Args a) {
    extern __shared__ __attribute__((aligned(16))) unsigned char lds_raw[];
    LAS unsigned char* lds = (LAS unsigned char*)lds_raw;
    {
        volatile LAS unsigned* Z = (volatile LAS unsigned*)(lds + RING_BYTES);
        for (int u = threadIdx.x; u < (LDS_BYTES - RING_BYTES) / 4; u += NTHREADS) Z[u] = 0u;
    }
    __syncthreads();
    XcdBarrier bar = xcd_barrier_post((unsigned*)((gu32*)(a.ws + WS_CTL) + CW_BAR), (volatile LAS unsigned*)(lds + MISC_OFF) + 8);
    const int lo = a.ph_lo, hi = a.ph_hi;
    const int wid0 = __builtin_amdgcn_readfirstlane(threadIdx.x >> 6);
#ifndef PHMASK
#define PHMASK 0xFFFF
#endif
#define EN(b) ((PHMASK >> (b)) & 1)
#define IN_PH(k) (lo <= (k) && (k) < hi)
#define SEAM(k) do { if ((k) + 1 < hi) xcd_barrier(bar); } while (0)
#ifndef REPMASK
#define REPMASK 0
#endif
#define REPS(b, cond) for (int rep_ = 0; rep_ < ((((REPMASK) >> (b)) & 1) && (cond) ? 2 : 1); ++rep_)
#define REPBAR() do { if (rep_) xcd_barrier(bar); } while (0)
#define PH_BEGIN() int l = l_, wid = wid0; unsigned z_ = 0u; asm volatile("" : "+s"(l), "+s"(wid), "+s"(z_)); int tid = wid * 64 + (int)__builtin_amdgcn_mbcnt_hi(~0u, __builtin_amdgcn_mbcnt_lo(~0u, z_)); asm volatile("" : "+v"(tid)); \
    const int lane = tid & 63; const int G = gridDim.x, bx = blockIdx.x; \
    const int vcu = (G % 8 == 0) ? (bx % 8) * (G / 8) + bx / 8 : bx; \
    const int gw = vcu * NWAVES + wid, ngw = G * NWAVES, gtid = vcu * NTHREADS + tid, gthreads = G * NTHREADS; \
    unsigned char* ws = a.ws; float* out = a.out; float* X = out; (void)lane; (void)wid; (void)gw; (void)ngw; (void)gtid; (void)gthreads; (void)ws; (void)X; (void)vcu; \
    const float* mod_l = (const float*)(ws + WS_MOD) + (size_t)l * NSEQ * NMOD; (void)mod_l
#define WSP(T, off) ((T*)(ws + (off)))

    if (EN(0) && IN_PH(0)) REPS(0, true) {
        const int l_ = 0; PH_BEGIN();
        for (int item = bx; item < 288; item += G) adaln_item(item, a.in[5], a.in[6], a.in[7], a.in[8], WSP(float, WS_MOD), lds, tid, wid, lane);
        LAS float* scr = (LAS float*)(lds + wid * 16384);
        const float *w_ff_up = a.in[10], *w_ff_down = a.in[11], *w_in = a.in[12], *w_out = a.in[13];
        { const int n2 = 288 > G ? 288 - G : 0;
          if (bx >= n2) for (int itm = (bx - n2) * NWAVES + wid; itm < I_LAYER; itm += (G - n2) * NWAVES) convert_layer_item(0, itm, w_ff_up, w_ff_down, w_in, w_out, ws, scr, lane); }
        SEAM(0);
    }

    for (int l_ = 0; l_ < 2; ++l_) {
        const int pb = 1 + l_ * NPL;
        if (EN(1) && IN_PH(pb + 0)) REPS(1, l_ == 0) { PH_BEGIN();
            const float* mod_prev = (const float*)(ws + WS_MOD);
            norm_phase(l == 0 ? a.in[0] : nullptr, l == 0 ? a.in[1] : nullptr, WSP(bf16_t, WS_XB), a.in[9] + (size_t)(l * 3 + 0) * D, mod_l, 0, WSP(bf16_t, WS_H), gw, ngw, lane, l == 0 ? nullptr : WSP(bf16_t, WS_PARTD), mod_prev + 8 * D, 0.5f); SEAM(pb + 0); }
        if (EN(2) && IN_PH(pb + 1)) REPS(2, true) { PH_BEGIN();
            pg8::Gemm g{WSP(bf16_t, WS_H), WSP(bf16_t, WS_WUP) + (size_t)(l * 2 + 0) * NUP * D, M, NUP, D}; TailOrder S; S.init(M, NUP, G, bx);
            EpiUp E{WSP(bf16_t, WS_ACT)};
            pg8::gemm_phase<EpiUp, TailOrder, true, true>(lds, g, S, E, tid);
            if (l == 0) background_convert(0, 4500, bx - 2 * S.rem, G - 2 * S.rem, wid, a.in[10], a.in[11], a.in[12], a.in[13], ws, lds, lane);
            SEAM(pb + 1);
        }
        if (EN(3) && IN_PH(pb + 2)) REPS(3, l_ == 0) { PH_BEGIN();
            pg8::Gemm g{WSP(bf16_t, WS_ACT), WSP(bf16_t, WS_WDN) + (size_t)(l * 2 + 0) * D * DFF, M, D, DFF}; SplitOrder S; S.init(G, bx, DFF / 64);
            EpiRes E{WSP(bf16_t, WS_XB), X, 0, mod_l + 2 * D, 0.5f, WSP(bf16_t, WS_PARTD)};
            pg8::gemm_phase<EpiRes, SplitOrder, true, true>(lds, g, S, E, tid);
            SEAM(pb + 2);
        }
        if (EN(1) && IN_PH(pb + 3)) REPS(1, l_ == 0) { PH_BEGIN(); norm_phase(nullptr, nullptr, WSP(bf16_t, WS_XB), a.in[9] + (size_t)(l * 3 + 1) * D, mod_l, 1, WSP(bf16_t, WS_H), gw, ngw, lane, WSP(bf16_t, WS_PARTD), mod_l + 2 * D, 0.5f); SEAM(pb + 3); }
        if (EN(4) && IN_PH(pb + 4)) REPS(4, true) { PH_BEGIN();
            pg8::Gemm g{WSP(bf16_t, WS_H), WSP(bf16_t, WS_WIN) + (size_t)l * DIN * D, M, DIN, D}; TailOrder S; S.init(M, DIN, G, bx);
            EpiIn E{WSP(bf16_t, WS_RQ), WSP(bf16_t, WS_RK), WSP(bf16_t, WS_RV), WSP(bf16_t, WS_SG), WSP(bf16_t, WS_DQ), WSP(bf16_t, WS_DK), WSP(bf16_t, WS_DV),
                    out + O_KP + (size_t)l * MP * 512, out + O_KS + (size_t)l * MS * 512, out + O_VP + (size_t)l * MP * 512, out + O_VS + (size_t)l * MS * 512, a.in[14] + (size_t)l * 128};
            pg8::gemm_phase<EpiIn, TailOrder, true, true>(lds, g, S, E, tid);
            if (l == 0) background_convert(4500, 5996, bx - 2 * S.rem, G - 2 * S.rem, wid, a.in[10], a.in[11], a.in[12], a.in[13], ws, lds, lane);
            SEAM(pb + 4);
        }
#define LAMBDA_SETUP() float lam, negm0; const float lam_init = l == 0 ? 0.2f : 0.35550906759096926f; { \
            const float* wl = a.in[15] + (size_t)l * 256; const float* gq_ = a.in[14] + (size_t)l * 128; \
            const float s1 = wave_sum(wl[lane] * wl[64 + lane]), s2 = wave_sum(wl[128 + lane] * wl[192 + lane]); \
            lam = __expf(s1) - __expf(s2) + lam_init; \
            const float gq = wave_max(fabsf(gq_[lane])), gk = wave_max(fabsf(gq_[64 + lane])); \
            negm0 = -(C2 * 64.0f * gq * gk * 1.02f); } \
            const float lscale = 1.0f - lam_init; const float* gsub_l = a.in[16] + (size_t)l * 128; (void)negm0; (void)lscale; (void)gsub_l
        if (IN_PH(pb + 5)) {
            { PH_BEGIN();
                const int role = (bx >> 3) & 1, r = (bx >> 4) * 8 + (bx & 7), nr = G >> 1;
                if (role == 0) {
                    LAMBDA_SETUP();
#pragma unroll 1
                    for (int unit = r; unit < 128; unit += nr)
                        attn_sample_unit(unit, a.in[2] + (size_t)l * 32 * 4096 * 512, a.in[3] + (size_t)l * 32 * 4096 * 512, WSP(bf16_t, WS_DQ), WSP(bf16_t, WS_DK), WSP(bf16_t, WS_DV), WSP(bf16_t, WS_MIX), gsub_l, lam, lscale, lds, tid, wid, lane);
                } else {
                    LAMBDA_SETUP();
#pragma unroll 1
                    for (int q = r; q < 256; q += nr) {
                        const int j = q >> 3, bh = 4 * (q & 7) + (j >> 3), s = j & 7;
#pragma unroll 1
                        for (int k = 0; k < 2; ++k)
                            attn_prompt_unit(bh >> 2, bh & 3, k ? 15 - s : s, WSP(bf16_t, WS_DQ), WSP(bf16_t, WS_DK), WSP(bf16_t, WS_DV), WSP(bf16_t, WS_MIX), gsub_l, lam, lscale, negm0, lds, tid, wid, lane);
                    }
                }
            }
            __syncthreads();
            if (EN(7)) REPS(9, true) { PH_BEGIN();
                st_sample_init(WSP(bf16_t, WS_SC), a.in[4] + (size_t)l * 128 * 8192, gtid, gthreads);
                for (int item = gw; item < 2304; item += ngw) ret_kv_item(item, WSP(bf16_t, WS_RK), WSP(bf16_t, WS_RV), WSP(unsigned short, WS_KV), lds + wid * 16384, lane);
            }
            SEAM(pb + 5);
        }
        if (IN_PH(pb + 6)) REPS(6, true) { PH_BEGIN(); LAMBDA_SETUP();
            if (EN(8)) scan_phase(WSP(unsigned short, WS_KV), WSP(bf16_t, WS_SC), a.in[4] + (size_t)l * 128 * 8192, out + O_SP + (size_t)l * 32 * 8192, out + O_SS + (size_t)l * 128 * 8192, gtid, gthreads, (wid * G + vcu) * 64 + lane);
            if (EN(9) && wid == 2) for (int item = 2048 + vcu; item < 2304; item += G) ret_out_item(item, WSP(bf16_t, WS_RQ), WSP(bf16_t, WS_RK), WSP(bf16_t, WS_RV), WSP(bf16_t, WS_SG), WSP(bf16_t, WS_SC), WSP(bf16_t, WS_MIX), lds + wid * 16384, lane);
            SEAM(pb + 6);
        }
        if (EN(9) && IN_PH(pb + 7)) REPS(7, true) { PH_BEGIN();
            for (int item = gw; item < 2048; item += ngw) ret_out_item(item, WSP(bf16_t, WS_RQ), WSP(bf16_t, WS_RK), WSP(bf16_t, WS_RV), WSP(bf16_t, WS_SG), WSP(bf16_t, WS_SC), WSP(bf16_t, WS_MIX), lds + wid * 16384, lane);
            SEAM(pb + 7);
        }
        if (EN(3) && IN_PH(pb + 8)) { PH_BEGIN();
            pg8::Gemm g{WSP(bf16_t, WS_MIX), WSP(bf16_t, WS_WOUT) + (size_t)l * D * D, M, D, D}; SplitOrder S; S.init(G, bx, D / 64);
            EpiRes E{WSP(bf16_t, WS_XB), X, 0, mod_l + 5 * D, 1.0f, WSP(bf16_t, WS_PARTD)};
            pg8::gemm_phase<EpiRes, SplitOrder, true, true>(lds, g, S, E, tid);
            SEAM(pb + 8);
        }
        if (EN(1) && IN_PH(pb + 9)) { PH_BEGIN(); norm_phase(nullptr, nullptr, WSP(bf16_t, WS_XB), a.in[9] + (size_t)(l * 3 + 2) * D, mod_l, 2, WSP(bf16_t, WS_H), gw, ngw, lane, WSP(bf16_t, WS_PARTD), mod_l + 5 * D, 1.0f); SEAM(pb + 9); }
        if (EN(2) && IN_PH(pb + 10)) REPS(2, true) { PH_BEGIN();
            pg8::Gemm g{WSP(bf16_t, WS_H), WSP(bf16_t, WS_WUP) + (size_t)(l * 2 + 1) * NUP * D, M, NUP, D}; TailOrder S; S.init(M, NUP, G, bx);
            EpiUp E{WSP(bf16_t, WS_ACT)};
            pg8::gemm_phase<EpiUp, TailOrder, true, true>(lds, g, S, E, tid);
            if (l == 0) background_convert(5996, I_LAYER, bx - 2 * S.rem, G - 2 * S.rem, wid, a.in[10], a.in[11], a.in[12], a.in[13], ws, lds, lane);
            SEAM(pb + 10);
        }
        if (EN(3) && IN_PH(pb + 11)) { PH_BEGIN();
            pg8::Gemm g{WSP(bf16_t, WS_ACT), WSP(bf16_t, WS_WDN) + (size_t)(l * 2 + 1) * D * DFF, M, D, DFF}; SplitOrder S; S.init(G, bx, DFF / 64);
            EpiRes E{WSP(bf16_t, WS_XB), X, l, mod_l + 8 * D, 0.5f, WSP(bf16_t, WS_PARTD)};
            pg8::gemm_phase<EpiRes, SplitOrder, true, true>(lds, g, S, E, tid);
            SEAM(pb + 11);
        }
    }
    if (IN_PH(1 + 2 * NPL)) { const int l_ = 1; PH_BEGIN();
        final_reduce(WSP(bf16_t, WS_PARTD), mod_l + 8 * D, 0.5f, WSP(bf16_t, WS_XB), X, gw, ngw, lane);
    }
#undef IN_PH
#undef SEAM
}

#ifndef MK_N_LAUNCHES
#define MK_N_LAUNCHES 1
#endif
extern "C" void kernel_launch(void* const* d_in, const int* in_sizes, int n_in, void* d_out, int out_size, void* d_ws, size_t ws_size, hipStream_t stream) {
    static int grid = 0;
    if (grid == 0) {
        if (n_in != 17 || ws_size < WS_END) { fprintf(stderr, "kernel_launch: unexpected n_in %d / ws %zu\n", n_in, ws_size); grid = -1; return; }
        int dev = 0, cus = 0, per_cu = 0;
        if (hipGetDevice(&dev) != hipSuccess || hipDeviceGetAttribute(&cus, hipDeviceAttributeMultiprocessorCount, dev) != hipSuccess) { grid = -1; return; }
        if (hipFuncSetAttribute((const void*)fwd_kernel, hipFuncAttributeMaxDynamicSharedMemorySize, LDS_BYTES) != hipSuccess) { fprintf(stderr, "kernel_launch: hipFuncSetAttribute failed\n"); grid = -1; return; }
        if (hipOccupancyMaxActiveBlocksPerMultiprocessor(&per_cu, (const void*)fwd_kernel, NTHREADS, LDS_BYTES) != hipSuccess || per_cu < 1)
            fprintf(stderr, "kernel_launch: occupancy query reports %d blocks per CU\n", per_cu);
        (void)hipGetLastError();
        grid = cus < 256 ? cus : 256;
    }
    if (grid < 0) return;
    if (hipMemsetAsync((char*)d_ws + WS_CTL, 0, CTL_ZERO_BYTES, stream) != hipSuccess) return;
    Args a{};
    for (int i = 0; i < 17; ++i) a.in[i] = (const float*)d_in[i];
    a.out = (float*)d_out; a.ws = (unsigned char*)d_ws;
    if (MK_N_LAUNCHES == 1) {
        a.ph_lo = 0; a.ph_hi = NPHASES;
        hipLaunchKernelGGL(fwd_kernel, dim3(grid), dim3(NTHREADS), LDS_BYTES, stream, a);
    } else {
        for (int p = 0; p < NPHASES; ++p) { a.ph_lo = p; a.ph_hi = p + 1; hipLaunchKernelGGL(fwd_kernel, dim3(grid), dim3(NTHREADS), LDS_BYTES, stream, a); }
    }
}
```
